# Optimizing an MI355X kernel written in HIP

```python
import jax, jax.numpy as jnp
from jax import lax
import numpy as np

D_MODEL = 1024
BATCH = 8
SEQ = 4096
DEPTH = 2

GRID_W = 64
CTX_LEN = 256
HG_WIDTH = D_MODEL // 2
HG_HEADS = HG_WIDTH // 128
HG_DK = HG_WIDTH // HG_HEADS
HG_DV = HG_DK
ML_WIDTH = D_MODEL - HG_WIDTH
ML_HEADS = 4
ML_DK = ML_WIDTH // ML_HEADS // 2
ML_DV = ML_WIDTH // ML_HEADS
ML_CONV = 3
MIX_WIDTH = HG_WIDTH + ML_WIDTH
PROJ_DIM = 5 * HG_WIDTH + 2 * ML_HEADS * ML_DK + 2 * ML_WIDTH + 4 * ML_HEADS
CHUNK = 64
D_FF = 2816
N_EXPERTS = 8
TOP_K = 2
D_EXPERT = D_FF // TOP_K
DEEPNORM_ALPHA = (2 * DEPTH) ** 0.25
DEEPNORM_BETA = (8 * DEPTH) ** -0.25
LN_EPS = 1e-5
RMS_EPS = 1e-6

kernel_name = "hgrn2_mlstm_hybrid_dit_moe"


def _layer_norm(x, g, b):
    xf = x.astype(jnp.float32)
    mu = jnp.mean(xf, axis=-1, keepdims=True)
    var = jnp.mean(jnp.square(xf - mu), axis=-1, keepdims=True)
    y = (xf - mu) * lax.rsqrt(var + LN_EPS) * g.astype(jnp.float32) + b.astype(jnp.float32)
    return y.astype(x.dtype)


def _head_rms(x, g):
    return x * lax.rsqrt(jnp.mean(x * x, axis=-1, keepdims=True) + RMS_EPS) * g.astype(jnp.float32)


def _centred_dwconv(u, w, b):
    width = w.shape[0]
    half = width // 2
    n = u.shape[-2]
    up = jnp.pad(u, [(0, 0)] * (u.ndim - 2) + [(half, half), (0, 0)])
    out = b
    for t in range(width):
        out = out + up[..., t:t + n, :] * w[t]
    return out


def _to_chunks(t):
    bsz, n, h = t.shape[:3]
    t = t.reshape(bsz, n // CHUNK, CHUNK, h, *t.shape[3:])
    return jnp.moveaxis(t, (1, 3), (0, 2))


def _from_chunks(t):
    n, bsz, h, c = t.shape[:4]
    return jnp.moveaxis(t, (0, 2), (1, 3)).reshape(bsz, n * c, h, *t.shape[4:])


def _hgrn2_scan(q, v, log_f, k, s0):
    causal = jnp.tril(jnp.ones((CHUNK, CHUNK), dtype=bool))[:, :, None]

    def step(s, xs):
        qc, vc, fc, kc = xs
        g = jnp.cumsum(fc, axis=2)
        decay = jnp.exp(jnp.where(causal, g[:, :, :, None, :] - g[:, :, None, :, :], -jnp.inf))
        a = jnp.einsum("bhid,bhjd,bhijd->bhij", qc, kc, decay)
        o = jnp.einsum("bhij,bhjv->bhiv", a, vc) + jnp.einsum("bhid,bhdv->bhiv", qc * jnp.exp(g), s)
        g_end = g[:, :, -1, :]
        s_new = jnp.exp(g_end)[..., None] * s + jnp.einsum(
            "bhjd,bhjv->bhdv", kc * jnp.exp(g_end[:, :, None, :] - g), vc)
        return s_new, o

    xs = (_to_chunks(q), _to_chunks(v), _to_chunks(log_f), _to_chunks(k))
    s_fin, o = lax.scan(step, s0, xs)
    return _from_chunks(o), s_fin


def _mlstm_scan(q, k, v, log_i, log_f, state):
    causal = jnp.tril(jnp.ones((CHUNK, CHUNK), dtype=bool))

    def step(carry, xs):
        c_prev, n_prev, m_prev = carry
        qc, kc, vc, ic, fc = xs
        b = jnp.cumsum(fc, axis=-1)
        d = jnp.where(causal, b[..., :, None] - b[..., None, :] + ic[..., None, :], -jnp.inf)
        inter = b + m_prev[..., None]
        m = jnp.maximum(jnp.max(d, axis=-1), inter)
        s = jnp.einsum("bhid,bhjd->bhij", qc, kc) * jnp.exp(d - m[..., None])
        w_inter = jnp.exp(inter - m)[..., None]
        num = jnp.einsum("bhij,bhjv->bhiv", s, vc) + w_inter * jnp.einsum("bhid,bhdv->bhiv", qc, c_prev)
        den = jnp.sum(s, axis=-1) + w_inter[..., 0] * jnp.einsum("bhid,bhd->bhi", qc, n_prev)
        h = num / jnp.maximum(jnp.abs(den), jnp.exp(-m))[..., None]
        m_new = m[..., -1]
        w_k = jnp.exp(b[..., -1:] - b + ic - m_new[..., None])[..., None] * kc
        dec = jnp.exp(b[..., -1] + m_prev - m_new)
        c_new = dec[..., None, None] * c_prev + jnp.einsum("bhjd,bhjv->bhdv", w_k, vc)
        n_new = dec[..., None] * n_prev + jnp.sum(w_k, axis=2)
        return (c_new, n_new, m_new), h

    xs = (_to_chunks(q), _to_chunks(k), _to_chunks(v), _to_chunks(log_i), _to_chunks(log_f))
    state, h = lax.scan(step, state, xs)
    return _from_chunks(h), state


def _bidir(scan_fn, shared, dirs, init):
    out_f, st_f = scan_fn(*shared, *dirs[0], init[0])
    flip = lambda t: jnp.flip(t, axis=1)
    out_b, st_b = scan_fn(*[flip(t) for t in shared], *[flip(t) for t in dirs[1]], init[1])
    return out_f + flip(out_b), (st_f, st_b)


def _stream_features(z, conv_w, conv_b, lb, gate_b, rows):
    bsz, n, _ = z.shape
    f32 = jnp.float32
    sizes = (HG_WIDTH,) * 5 + (2 * ML_HEADS * ML_DK, ML_WIDTH, 4 * ML_HEADS, ML_WIDTH)
    cuts, acc = [], 0
    for s in sizes[:-1]:
        acc += s
        cuts.append(acc)
    hq, hf_fwd, hf_bwd, hi, hg, mqk, mv, mgates, mo = jnp.split(z, cuts, axis=-1)
    hg_dirs = []
    for zf, lbd in ((hf_fwd, lb[0]), (hf_bwd, lb[1])):
        zf = zf.astype(f32)
        lbd = lbd.astype(f32)
        log_f = jnp.logaddexp(jnp.log(lbd), jnp.log1p(-lbd) + jax.nn.log_sigmoid(zf))
        k = (1.0 - lbd) * jax.nn.sigmoid(-zf)
        hg_dirs.append((log_f.reshape(bsz, n, HG_HEADS, HG_DK), k.reshape(bsz, n, HG_HEADS, HG_DK)))
    if rows is None:
        qk = _centred_dwconv(mqk, conv_w, conv_b)
    else:
        qk = _centred_dwconv(mqk.reshape(bsz, rows, GRID_W, -1), conv_w, conv_b).reshape(bsz, n, -1)
    mq, mk = jnp.split(jax.nn.silu(qk), 2, axis=-1)
    gates = (mgates.astype(f32) + gate_b.reshape(-1).astype(f32)).reshape(bsz, n, 2, 2, ML_HEADS)
    ml_dirs = [(gates[:, :, d, 0], jax.nn.log_sigmoid(gates[:, :, d, 1])) for d in range(2)]
    return {
        "hg_q": jax.nn.silu(hq).astype(f32).reshape(bsz, n, HG_HEADS, HG_DK),
        "hg_v": hi.astype(f32).reshape(bsz, n, HG_HEADS, HG_DV),
        "hg_dirs": hg_dirs,
        "hg_gate": hg,
        "ml_q": mq.astype(f32).reshape(bsz, n, ML_HEADS, ML_DK) * (ML_DK ** -0.5),
        "ml_k": mk.astype(f32).reshape(bsz, n, ML_HEADS, ML_DK),
        "ml_v": mv.astype(f32).reshape(bsz, n, ML_HEADS, ML_DV),
        "ml_dirs": ml_dirs,
        "ml_gate": mo,
    }


def _mix_out(hg_o, ml_h, feats, hg_norm, ml_norm, w_out, dtype):
    bsz, n = hg_o.shape[:2]
    hg = _head_rms(hg_o, hg_norm) * jax.nn.silu(feats["hg_gate"].astype(jnp.float32)).reshape(bsz, n, HG_HEADS, HG_DV)
    ml = _head_rms(ml_h, ml_norm) * jax.nn.sigmoid(feats["ml_gate"].astype(jnp.float32)).reshape(bsz, n, ML_HEADS, ML_DV)
    y = jnp.concatenate([hg.reshape(bsz, n, HG_WIDTH), ml.reshape(bsz, n, ML_WIDTH)], axis=-1)
    return y.astype(dtype) @ w_out


def _token_mix(hx, hc, rows, w_in, conv_w, conv_b, lb, gate_b, hg_norm, ml_norm, w_out, with_ctx_out):
    bsz = hx.shape[0]
    f32 = jnp.float32
    fx = _stream_features(hx @ w_in, conv_w, conv_b, lb, gate_b, rows)
    fc = _stream_features(hc @ w_in, conv_w, conv_b, lb, gate_b, None)
    hg0 = jnp.zeros((bsz, HG_HEADS, HG_DK, HG_DV), f32)
    ml0 = (jnp.zeros((bsz, ML_HEADS, ML_DK, ML_DV), f32), jnp.zeros((bsz, ML_HEADS, ML_DK), f32),
           jnp.zeros((bsz, ML_HEADS), f32))
    hg_c, hg_state = _bidir(_hgrn2_scan, (fc["hg_q"], fc["hg_v"]), fc["hg_dirs"], (hg0, hg0))
    ml_c, ml_state = _bidir(_mlstm_scan, (fc["ml_q"], fc["ml_k"], fc["ml_v"]), fc["ml_dirs"], (ml0, ml0))
    hg_x, _ = _bidir(_hgrn2_scan, (fx["hg_q"], fx["hg_v"]), fx["hg_dirs"], hg_state)
    ml_x, _ = _bidir(_mlstm_scan, (fx["ml_q"], fx["ml_k"], fx["ml_v"]), fx["ml_dirs"], ml_state)
    out_x = _mix_out(hg_x, ml_x, fx, hg_norm, ml_norm, w_out, hx.dtype)
    out_c = _mix_out(hg_c, ml_c, fc, hg_norm, ml_norm, w_out, hc.dtype) if with_ctx_out else None
    return out_x, out_c


def _swiglu(h, w_gate_up, w_down):
    gate, up = jnp.split(h @ w_gate_up, 2, axis=-1)
    return (jax.nn.silu(gate) * up) @ w_down


def _moe_swiglu(h, router_w, router_b, w_gate_up, w_down):
    logits = (h @ router_w).astype(jnp.float32) + router_b.astype(jnp.float32)
    top_val, top_idx = lax.top_k(logits, TOP_K)
    top_p = jax.nn.softmax(top_val, axis=-1)
    combine = jnp.einsum("blk,blke->ble", top_p, jax.nn.one_hot(top_idx, N_EXPERTS, dtype=jnp.float32)).astype(h.dtype)
    out = jnp.zeros_like(h)
    for e in range(N_EXPERTS):
        out = out + combine[..., e:e + 1] * _swiglu(h, w_gate_up[e], w_down[e])
    return out


def _channel_mix(h, layer, ffn_w_gate_up, ffn_w_down, router_w, router_b, moe_w_gate_up, moe_w_down):
    j = layer // 2
    if layer % 2 == 0:
        return _swiglu(h, ffn_w_gate_up[j], ffn_w_down[j])
    return _moe_swiglu(h, router_w[j], router_b[j], moe_w_gate_up[j], moe_w_down[j])


def setup_inputs(seed: int = 0) -> dict:
    key = jax.random.key(seed)
    ks = jax.random.split(key, 24)
    nrm = jax.random.normal
    f32 = jnp.float32
    n_dense = (DEPTH + 1) // 2
    n_moe = DEPTH // 2
    d_in = D_MODEL ** -0.5
    ig_b = 0.1 * nrm(ks[10], (DEPTH, 2, 1, ML_HEADS), f32)
    fg_b = jnp.linspace(3.0, 6.0, ML_HEADS, dtype=f32) + 0.1 * nrm(ks[11], (DEPTH, 2, 1, ML_HEADS), f32)
    return {
        "x": nrm(ks[0], (BATCH, SEQ, D_MODEL), f32),
        "c": nrm(ks[1], (BATCH, D_MODEL), f32),
        "ctx": nrm(ks[2], (BATCH, CTX_LEN, D_MODEL), f32),
        "c_ctx": nrm(ks[3], (D_MODEL,), f32),
        "w_ada": 0.5 * d_in * nrm(ks[4], (DEPTH, D_MODEL, 6 * D_MODEL), f32),
        "b_ada": 0.02 * nrm(ks[5], (DEPTH, 6 * D_MODEL), f32),
        "w_in": d_in * nrm(ks[6], (DEPTH, D_MODEL, PROJ_DIM), f32),
        "ml_conv_w": (ML_CONV ** -0.5) * nrm(ks[7], (DEPTH, ML_CONV, 2 * ML_HEADS * ML_DK), f32),
        "ml_conv_b": 0.02 * nrm(ks[8], (DEPTH, 2 * ML_HEADS * ML_DK), f32),
        "hg_lower_bound": 0.1 * nrm(ks[9], (DEPTH, 2, HG_WIDTH), f32),
        "ml_gate_bias": jnp.concatenate([ig_b, fg_b], axis=2),
        "hg_norm": 1.0 + 0.05 * nrm(ks[12], (DEPTH, HG_HEADS, HG_DV), f32),
        "ml_norm": 1.0 + 0.05 * nrm(ks[13], (DEPTH, ML_HEADS, ML_DV), f32),
        "w_out": DEEPNORM_BETA * (MIX_WIDTH ** -0.5) * nrm(ks[14], (DEPTH, MIX_WIDTH, D_MODEL), f32),
        "ln_g": 1.0 + 0.05 * nrm(ks[15], (DEPTH, 2, D_MODEL), f32),
        "ln_b": 0.02 * nrm(ks[16], (DEPTH, 2, D_MODEL), f32),
        "ffn_w_gate_up": d_in * nrm(ks[17], (n_dense, D_MODEL, 2 * D_FF), f32),
        "ffn_w_down": DEEPNORM_BETA * (D_FF ** -0.5) * nrm(ks[18], (n_dense, D_FF, D_MODEL), f32),
        "router_w": d_in * nrm(ks[19], (n_moe, D_MODEL, N_EXPERTS), f32),
        "router_b": 0.01 * nrm(ks[20], (n_moe, N_EXPERTS), f32),
        "moe_w_gate_up": d_in * nrm(ks[21], (n_moe, N_EXPERTS, D_MODEL, 2 * D_EXPERT), f32),
        "moe_w_down": DEEPNORM_BETA * (D_EXPERT ** -0.5) * nrm(ks[22], (n_moe, N_EXPERTS, D_EXPERT, D_MODEL), f32),
    }


def reference(x, c, ctx, c_ctx, w_ada, b_ada, w_in, ml_conv_w, ml_conv_b, hg_lower_bound, ml_gate_bias,
              hg_norm, ml_norm, w_out, ln_g, ln_b, ffn_w_gate_up, ffn_w_down, router_w, router_b,
              moe_w_gate_up, moe_w_down):
    bsz, seq, d = x.shape
    rows = seq // GRID_W
    lb_all = jnp.cumsum(jax.nn.softmax(hg_lower_bound.astype(jnp.float32), axis=0), axis=0)
    lb_all = lb_all - lb_all[0]
    cond_x = jax.nn.silu(c)
    cond_c = jax.nn.silu(c_ctx)
    for l in range(DEPTH):
        last = l == DEPTH - 1
        mod_x = (cond_x @ w_ada[l] + b_ada[l]).reshape(bsz, 6, 1, d)
        mod_c = (cond_c @ w_ada[l] + b_ada[l]).reshape(6, 1, d)
        hx = x * (1.0 + mod_x[:, 1]) + mod_x[:, 0]
        hc = ctx * (1.0 + mod_c[1]) + mod_c[0]
        mix_x, mix_c = _token_mix(hx, hc, rows, w_in[l], ml_conv_w[l], ml_conv_b[l], lb_all[l], ml_gate_bias[l],
                                  hg_norm[l], ml_norm[l], w_out[l], not last)
        x = _layer_norm(DEEPNORM_ALPHA * x + mod_x[:, 2] * mix_x, ln_g[l, 0], ln_b[l, 0])
        if not last:
            ctx = _layer_norm(DEEPNORM_ALPHA * ctx + mod_c[2] * mix_c, ln_g[l, 0], ln_b[l, 0])
        hx = x * (1.0 + mod_x[:, 4]) + mod_x[:, 3]
        f_x = _channel_mix(hx, l, ffn_w_gate_up, ffn_w_down, router_w, router_b, moe_w_gate_up, moe_w_down)
        x = _layer_norm(DEEPNORM_ALPHA * x + mod_x[:, 5] * f_x, ln_g[l, 1], ln_b[l, 1])
        if not last:
            hc = ctx * (1.0 + mod_c[4]) + mod_c[3]
            f_c = _channel_mix(hc, l, ffn_w_gate_up, ffn_w_down, router_w, router_b, moe_w_gate_up, moe_w_down)
            ctx = _layer_norm(DEEPNORM_ALPHA * ctx + mod_c[5] * f_c, ln_g[l, 1], ln_b[l, 1])
    return x
```

```cpp
#include <hip/hip_runtime.h>
#include <cstdio>
#include <cstdint>

constexpr int DM = 1024, NBATCH = 8, SEQ = 4096, CTXL = 256, DEPTH = 2;
constexpr int M_LAT = NBATCH * SEQ;
constexpr int M_CTX = NBATCH * CTXL;
constexpr int M_ALL = M_LAT + M_CTX;
constexpr int PROJ = 4112;
constexpr int ZLD = 4096;
constexpr int ZC_HQ = 0, ZC_HF0 = 512, ZC_HF1 = 1024, ZC_HI = 1536, ZC_HG = 2048, ZC_MQ = 2560, ZC_MK = 2816, ZC_MV = 3072, ZC_MO = 3584;
constexpr int DFF = 2816, NEXP = 8, DEXP = 1408;
constexpr float LN_EPS = 1e-5f, RMS_EPS = 1e-6f;
constexpr float DN_ALPHA = 1.41421356237309515f;
constexpr int NWAVES = 8, NTHREADS = 512;

namespace pg8 {
#define PG8_LAS __attribute__((address_space(3)))
typedef unsigned short bf16_t;
typedef short bf16x8 __attribute__((ext_vector_type(8)));
typedef float f32x4 __attribute__((ext_vector_type(4)));
typedef unsigned u32x4 __attribute__((ext_vector_type(4)));
constexpr int BM = 256, BK = 64, HALF = 128, HTB = HALF * BK * 2  , STAGE_BYTES = 8 * HTB, NXCD = 8, WGM = 8;

__host__ __device__ __forceinline__ int lds_byte(int r, int c) { const int st = (r >> 4) * 2 + (c >> 5), rr = r & 15, cc = c & 31, ob = rr * 64 + cc * 2; return st * 1024 + (ob ^ (((ob >> 9) & 1) << 5)); }
__host__ __device__ __forceinline__ void stage_rc(int b, int& R, int& C) { const int st = b / 1024, sb = b % 1024, swz = sb ^ (((sb >> 9) & 1) << 5); R = (st >> 1) * 16 + swz / 64; C = (st & 1) * 32 + (swz % 64) / 2; }
__host__ __device__ __forceinline__ int perm32(int rho) { const int n = rho >> 4, i = rho & 15; return 8 * (i >> 2) + 4 * n + (i & 3); }

struct Unit { int pm, pn; };
struct Gemm { const bf16_t* A; const bf16_t* Bt; int M, N, K; };

struct StaticOrder {
    int nM, nN, nwg, G, c;
    __host__ __device__ void init(int M, int N, int G_, int c_) { nM = M / BM; nN = N / BM; nwg = nM * nN; G = G_; c = c_; }
    __host__ __device__ bool next(int i, Unit& u) const {
        const long L = (long)i * G + c; if (L >= nwg) return false;
        int wgid = (int)L; { const int q = nwg / NXCD, r = nwg % NXCD, xcd = wgid % NXCD, off = wgid / NXCD; wgid = (xcd < r ? xcd * (q + 1) : r * (q + 1) + (xcd - r) * q) + off; }
        const int nig = WGM * nN, gid = wgid / nig, fm = gid * WGM, gsz = (nM - fm) < WGM ? (nM - fm) : WGM;
        u.pm = fm + ((wgid % nig) % gsz); u.pn = (wgid % nig) / gsz; return true;
    }
    __device__ __forceinline__ void a_ready(const Unit&) const {}
    __device__ __forceinline__ void done(const Unit&) const {}
};
typedef __bf16 bf16x2_nat __attribute__((ext_vector_type(2)));
typedef float f32x2_nat __attribute__((ext_vector_type(2)));
__device__ __forceinline__ unsigned cvt_pk_bf16(float lo, float hi) { const f32x2_nat v = {lo, hi}; const bf16x2_nat r = __builtin_convertvector(v, bf16x2_nat); return __builtin_bit_cast(unsigned, r); }
__device__ __forceinline__ float fsigmoid(float x) { return __builtin_amdgcn_rcpf(1.0f + __expf(-x)); }
__device__ __forceinline__ float fsilu(float x) { return x * fsigmoid(x); }
__device__ __forceinline__ f32x4 silu4(f32x4 v) { return (f32x4){fsilu(v[0]), fsilu(v[1]), fsilu(v[2]), fsilu(v[3])}; }
__device__ __forceinline__ f32x4 sigm4(f32x4 v) { return (f32x4){fsigmoid(v[0]), fsigmoid(v[1]), fsigmoid(v[2]), fsigmoid(v[3])}; }
__device__ __forceinline__ float flogf1(float z, float lb) { z = fminf(fmaxf(z, -30.f), 30.f); const float s = fsigmoid(z); return __logf(lb + (1.0f - lb) * s); }
__device__ __forceinline__ f32x4 logf4(f32x4 v, f32x4 lb) { return (f32x4){flogf1(v[0], lb[0]), flogf1(v[1], lb[1]), flogf1(v[2], lb[2]), flogf1(v[3], lb[3])}; }
__device__ __forceinline__ u32x4 pack8(f32x4 v0, f32x4 v1) { u32x4 w; w.x = cvt_pk_bf16(v0[0], v0[1]); w.y = cvt_pk_bf16(v0[2], v0[3]); w.z = cvt_pk_bf16(v1[0], v1[1]); w.w = cvt_pk_bf16(v1[2], v1[3]); return w; }

struct EpiZ {
    static constexpr bool PERM = true, AFTER_DRAIN = false;
    bf16_t* O; const float* lbv;
    __device__ __forceinline__ void operator()(const f32x4 (&acc)[2][2][4][2], const Unit& u, int wr, int wc, int fr, int fq) const {
        const int row0 = u.pm * BM + wr * 64 + fr, col0 = u.pn * BM + wc * 32 + 8 * fq;
        const int grp = u.pn >> 1;
        const int mode = (grp == 0 || grp == 4) ? 1 : ((grp == 1 || grp == 2) ? 2 : (grp == 7 ? 3 : 0));
        if (mode == 2) {
            f32x4 lb[2][2];
#pragma unroll
            for (int bj = 0; bj < 2; ++bj)
#pragma unroll
                for (int n = 0; n < 2; ++n) lb[bj][n] = *(const f32x4*)(lbv + (col0 - 512) + bj * HALF + 4 * n);
#pragma unroll
            for (int ai = 0; ai < 2; ++ai)
#pragma unroll
                for (int m = 0; m < 4; ++m) { bf16_t* rowp = O + (size_t)(row0 + ai * HALF + m * 16) * 4096 + col0;
#pragma unroll
                    for (int bj = 0; bj < 2; ++bj) *(u32x4*)(rowp + bj * HALF) = pack8(logf4(acc[ai][bj][m][0], lb[bj][0]), logf4(acc[ai][bj][m][1], lb[bj][1])); }
        } else if (mode == 1) {
#pragma unroll
            for (int ai = 0; ai < 2; ++ai)
#pragma unroll
                for (int m = 0; m < 4; ++m) { bf16_t* rowp = O + (size_t)(row0 + ai * HALF + m * 16) * 4096 + col0;
#pragma unroll
                    for (int bj = 0; bj < 2; ++bj) *(u32x4*)(rowp + bj * HALF) = pack8(silu4(acc[ai][bj][m][0]), silu4(acc[ai][bj][m][1])); }
        } else if (mode == 3) {
#pragma unroll
            for (int ai = 0; ai < 2; ++ai)
#pragma unroll
                for (int m = 0; m < 4; ++m) { bf16_t* rowp = O + (size_t)(row0 + ai * HALF + m * 16) * 4096 + col0;
#pragma unroll
                    for (int bj = 0; bj < 2; ++bj) *(u32x4*)(rowp + bj * HALF) = pack8(sigm4(acc[ai][bj][m][0]), sigm4(acc[ai][bj][m][1])); }
        } else {
#pragma unroll
            for (int ai = 0; ai < 2; ++ai)
#pragma unroll
                for (int m = 0; m < 4; ++m) { bf16_t* rowp = O + (size_t)(row0 + ai * HALF + m * 16) * 4096 + col0;
#pragma unroll
                    for (int bj = 0; bj < 2; ++bj) *(u32x4*)(rowp + bj * HALF) = pack8(acc[ai][bj][m][0], acc[ai][bj][m][1]); }
        }
    }
};
struct EpiPlain {
    static constexpr bool PERM = true, AFTER_DRAIN = false;
    bf16_t* O; int ldc;
    __device__ __forceinline__ void operator()(const f32x4 (&acc)[2][2][4][2], const Unit& u, int wr, int wc, int fr, int fq) const {
        const int row0 = u.pm * BM + wr * 64 + fr, col0 = u.pn * BM + wc * 32 + 8 * fq;
#pragma unroll
        for (int ai = 0; ai < 2; ++ai)
#pragma unroll
            for (int m = 0; m < 4; ++m) { bf16_t* rowp = O + (size_t)(row0 + ai * HALF + m * 16) * ldc + col0;
#pragma unroll
                for (int bj = 0; bj < 2; ++bj) *(u32x4*)(rowp + bj * HALF) = pack8(acc[ai][bj][m][0], acc[ai][bj][m][1]); }
    }
};
struct EpiSwiGLU {
    static constexpr bool PERM = true, AFTER_DRAIN = false;
    bf16_t* H; int ldh; int pn_mod;
    __device__ __forceinline__ void operator()(const f32x4 (&acc)[2][2][4][2], const Unit& u, int wr, int wc, int fr, int fq) const {
        const int row0 = u.pm * BM + wr * 64 + fr, col0 = (u.pn % pn_mod) * HALF + wc * 32 + 8 * fq;
#pragma unroll
        for (int ai = 0; ai < 2; ++ai)
#pragma unroll
            for (int m = 0; m < 4; ++m) { bf16_t* rowp = H + (size_t)(row0 + ai * HALF + m * 16) * ldh + col0;
                *(u32x4*)rowp = pack8(silu4(acc[ai][0][m][0]) * acc[ai][1][m][0], silu4(acc[ai][0][m][1]) * acc[ai][1][m][1]); }
    }
};
template <class Epi, class Sched, bool ALIGN_EPI = false, bool SP2 = false>
__device__ __forceinline__ void gemm_phase(PG8_LAS unsigned char* lds, const Gemm g, const Sched& S, const Epi& E) {
    int tid_ = threadIdx.x; asm volatile("" : "+v"(tid_));
    const int tid = tid_, wid = __builtin_amdgcn_readfirstlane(tid >> 6), lane = tid & 63, wr = wid >> 2, wc = wid & 3, fr = lane & 15, fq = lane >> 4;
    const int K = g.K, nt = K / BK;
    unsigned voffA[2], voffB[2];
#pragma unroll
    for (int i = 0; i < 2; ++i) { int R, C; stage_rc(tid * 16 + i * 8192, R, C); const int Rb = Epi::PERM ? ((R & ~31) + perm32(R & 31)) : R;
        voffA[i] = (unsigned)(R * K + C) * 2u; voffB[i] = (unsigned)(Rb * K + C) * 2u; }
    const size_t kstep = (size_t)(BK * 2);
    const size_t hstep = (size_t)HALF * K * 2;
    const size_t tstep = 2 * hstep;
    const unsigned ldsw = (unsigned)wid * 1024u;
    const int aoff = lds_byte(wr * 64 + fr, fq * 8), boff = lds_byte(wc * 32 + fr, fq * 8);
#define PG8_SA(b, h) (((b) * 2 + (h)) * HTB)
#define PG8_SB(b, h) ((4 + (b) * 2 + (h)) * HTB)
#define PG8_STAGE(bufoff, gbase, voff) do { _Pragma("unroll") for (int _i = 0; _i < 2; ++_i) \
        __builtin_amdgcn_global_load_lds((const unsigned*)((const char*)(gbase) + (voff)[_i]), (PG8_LAS unsigned*)(lds + (bufoff) + ldsw + _i * 8192), 16, 0, 0); } while (0)
#define PG8_LDA(dst, b, h) do { _Pragma("unroll") for (int m = 0; m < 4; ++m) _Pragma("unroll") for (int k = 0; k < 2; ++k) dst[m][k] = *(const PG8_LAS bf16x8*)(lds + PG8_SA(b, h) + aoff + m * 2048 + k * 1024); } while (0)
#define PG8_LDB(dst, b, h) do { _Pragma("unroll") for (int n = 0; n < 2; ++n) _Pragma("unroll") for (int k = 0; k < 2; ++k) dst[n][k] = *(const PG8_LAS bf16x8*)(lds + PG8_SB(b, h) + boff + n * 2048 + k * 1024); } while (0)
#define PG8_MMA(ai, bj, At, Bt) do { __builtin_amdgcn_s_setprio(1); _Pragma("unroll") for (int m = 0; m < 4; ++m) _Pragma("unroll") for (int n = 0; n < 2; ++n) _Pragma("unroll") for (int k = 0; k < 2; ++k) \
        acc[ai][bj][m][n] = __builtin_amdgcn_mfma_f32_16x16x32_bf16(Bt[n][k], At[m][k], acc[ai][bj][m][n], 0, 0, 0); __builtin_amdgcn_s_setprio(0); } while (0)
#define PG8_WAIT_V(n) asm volatile("s_waitcnt vmcnt(" #n ")" ::: "memory")
#define PG8_WAIT_L(n) asm volatile("s_waitcnt lgkmcnt(" #n ")" ::: "memory")
#define PG8_BAR __builtin_amdgcn_s_barrier()
#define PG8_SCHED __builtin_amdgcn_sched_barrier(0)
    Unit cur, nxt; int ui = 0;
    if (!S.next(0, cur)) return;
    f32x4 acc[2][2][4][2];
#pragma unroll
    for (int a = 0; a < 2; ++a)
#pragma unroll
        for (int b = 0; b < 2; ++b)
#pragma unroll
            for (int m = 0; m < 4; ++m)
#pragma unroll
                for (int n = 0; n < 2; ++n) acc[a][b][m][n] = (f32x4){0.f, 0.f, 0.f, 0.f};
    bf16x8 At[4][2], B0[2][2], B1[2][2];
    const char* cA = (const char*)g.A + (size_t)cur.pm * tstep; const char* cB = (const char*)g.Bt + (size_t)cur.pn * tstep;
    S.a_ready(cur);
    if constexpr (SP2) {
        PG8_STAGE(PG8_SB(0, 0), cB, voffB); PG8_STAGE(PG8_SB(0, 1), cB + hstep, voffB); PG8_STAGE(PG8_SA(0, 0), cA, voffA); PG8_STAGE(PG8_SA(0, 1), cA + hstep, voffA);
        if (wr == 1) PG8_BAR;
        PG8_WAIT_V(2); PG8_BAR;
        PG8_STAGE(PG8_SB(1, 0), cB + kstep, voffB); PG8_STAGE(PG8_SA(1, 0), cA + kstep, voffA); PG8_STAGE(PG8_SB(1, 1), cB + hstep + kstep, voffB);
        PG8_WAIT_V(6); PG8_BAR;
    } else {
        PG8_STAGE(PG8_SB(0, 0), cB, voffB); PG8_STAGE(PG8_SA(0, 0), cA, voffA); PG8_STAGE(PG8_SB(0, 1), cB + hstep, voffB); PG8_STAGE(PG8_SA(0, 1), cA + hstep, voffA);
        if (wr == 1) PG8_BAR;
        PG8_WAIT_V(4); PG8_BAR;
        PG8_STAGE(PG8_SB(1, 0), cB + kstep, voffB); PG8_STAGE(PG8_SA(1, 0), cA + kstep, voffA); PG8_STAGE(PG8_SB(1, 1), cB + hstep + kstep, voffB);
        PG8_WAIT_V(6); PG8_BAR;
    }
    for (;;) {
        const bool has_next = S.next(ui + 1, nxt);
        const char* nA = has_next ? (const char*)g.A + (size_t)nxt.pm * tstep : cA; const char* nB = has_next ? (const char*)g.Bt + (size_t)nxt.pn * tstep : cB;
        for (int t = 0; t < nt; t += 2) {
            const bool last = (t == nt - 2);
            const char* a1 = cA + (size_t)(t + 1) * kstep;
            const char* a2 = last ? nA : cA + (size_t)(t + 2) * kstep; const char* b2 = last ? nB : cB + (size_t)(t + 2) * kstep;
            const char* a3 = a2 + kstep; const char* b3 = b2 + kstep;
            if (last && has_next) S.a_ready(nxt);
            if constexpr (SP2) {
            PG8_LDB(B0, 0, 0); PG8_LDB(B1, 0, 1); PG8_SCHED; PG8_LDA(At, 0, 0); PG8_STAGE(PG8_SA(1, 1), a1 + hstep, voffA);
            PG8_WAIT_V(8); PG8_WAIT_L(0); PG8_BAR; PG8_MMA(0, 0, At, B0); PG8_MMA(0, 1, At, B1); PG8_BAR; PG8_SCHED;
            PG8_LDA(At, 0, 1); PG8_STAGE(PG8_SB(0, 0), b2, voffB); PG8_STAGE(PG8_SB(0, 1), b2 + hstep, voffB); PG8_STAGE(PG8_SA(0, 0), a2, voffA);
            PG8_WAIT_V(8); PG8_WAIT_L(0); PG8_BAR; PG8_MMA(1, 0, At, B0); PG8_MMA(1, 1, At, B1); PG8_BAR; PG8_SCHED;
            PG8_LDB(B0, 1, 0); PG8_LDB(B1, 1, 1); PG8_SCHED; PG8_LDA(At, 1, 0); PG8_STAGE(PG8_SA(0, 1), a2 + hstep, voffA);
            PG8_WAIT_V(8); PG8_WAIT_L(0); PG8_BAR; PG8_MMA(0, 0, At, B0); PG8_MMA(0, 1, At, B1); PG8_BAR; PG8_SCHED;
            PG8_LDA(At, 1, 1); PG8_STAGE(PG8_SB(1, 0), b3, voffB); PG8_STAGE(PG8_SB(1, 1), b3 + hstep, voffB); PG8_STAGE(PG8_SA(1, 0), a3, voffA);
            PG8_WAIT_V(8); PG8_WAIT_L(0); PG8_BAR; PG8_MMA(1, 0, At, B0); PG8_MMA(1, 1, At, B1); PG8_BAR; PG8_SCHED;
            } else {
            PG8_LDB(B0, 0, 0); PG8_SCHED; PG8_LDA(At, 0, 0); PG8_STAGE(PG8_SA(1, 1), a1 + hstep, voffA);
            PG8_WAIT_L(8); PG8_BAR; PG8_WAIT_L(0); PG8_MMA(0, 0, At, B0); PG8_BAR; PG8_SCHED;
            PG8_LDB(B1, 0, 1); PG8_STAGE(PG8_SB(0, 0), b2, voffB);
            PG8_BAR; PG8_WAIT_L(0); PG8_MMA(0, 1, At, B1); PG8_BAR;
            PG8_LDA(At, 0, 1); PG8_STAGE(PG8_SA(0, 0), a2, voffA);
            PG8_BAR; PG8_WAIT_L(0); PG8_MMA(1, 0, At, B0); PG8_BAR; PG8_SCHED;
            PG8_STAGE(PG8_SB(0, 1), b2 + hstep, voffB);
            PG8_WAIT_V(6); PG8_BAR; PG8_MMA(1, 1, At, B1); PG8_BAR;
            PG8_LDB(B0, 1, 0); PG8_SCHED; PG8_LDA(At, 1, 0); PG8_STAGE(PG8_SA(0, 1), a2 + hstep, voffA);
            PG8_WAIT_L(8); PG8_BAR; PG8_WAIT_L(0); PG8_MMA(0, 0, At, B0); PG8_BAR; PG8_SCHED;
            PG8_LDB(B1, 1, 1); PG8_STAGE(PG8_SB(1, 0), b3, voffB);
            PG8_BAR; PG8_WAIT_L(0); PG8_MMA(0, 1, At, B1); PG8_BAR;
            PG8_LDA(At, 1, 1); PG8_STAGE(PG8_SA(1, 0), a3, voffA);
            PG8_BAR; PG8_WAIT_L(0); PG8_MMA(1, 0, At, B0); PG8_BAR; PG8_SCHED;
            PG8_STAGE(PG8_SB(1, 1), b3 + hstep, voffB);
            PG8_WAIT_V(6); PG8_BAR; PG8_MMA(1, 1, At, B1); PG8_BAR;
            }
        }
        if constexpr (ALIGN_EPI) { if (wr == 0) PG8_BAR; }
        if constexpr (!Epi::AFTER_DRAIN) { E(acc, cur, wr, wc, fr, fq); S.done(cur); }
        if (!has_next) break;
#pragma unroll
        for (int a = 0; a < 2; ++a)
#pragma unroll
            for (int b = 0; b < 2; ++b)
#pragma unroll
                for (int m = 0; m < 4; ++m)
#pragma unroll
                    for (int n = 0; n < 2; ++n) acc[a][b][m][n] = (f32x4){0.f, 0.f, 0.f, 0.f};
        cur = nxt; cA = nA; cB = nB; ++ui;
        if constexpr (ALIGN_EPI) { if (wr == 1) PG8_BAR; }
    }
    PG8_WAIT_V(0);
    if constexpr (!ALIGN_EPI) { if (wr == 0) PG8_BAR; }
    PG8_BAR;
    if constexpr (Epi::AFTER_DRAIN) { E.fused(acc, cur, wr, wc, fr, fq, lds, wid, lane); S.done(cur); }
#undef PG8_SA
#undef PG8_SB
#undef PG8_STAGE
#undef PG8_LDA
#undef PG8_LDB
#undef PG8_MMA
#undef PG8_WAIT_V
#undef PG8_WAIT_L
#undef PG8_BAR
#undef PG8_SCHED
}
}
constexpr size_t MiB = 1u << 20;
constexpr size_t WS_CTL = 0, CTL_ZERO_BYTES = 1 * MiB;
constexpr size_t WS_MODF = 1 * MiB;
constexpr size_t WS_LBV = 1 * MiB + 512 * 1024;
constexpr size_t WS_GATES = 2 * MiB;
constexpr size_t WS_TOPE = 5 * MiB;
constexpr size_t WS_TOPP = 5 * MiB + 256 * 1024;
constexpr size_t WS_STATE = 8 * MiB;
constexpr size_t WS_XC = 24 * MiB;
constexpr size_t WS_CFB = 32 * MiB;
constexpr size_t WS_WIN0 = 40 * MiB, WS_WOUT0 = 48 * MiB, WS_FGU = 50 * MiB, WS_FDN = 61 * MiB, WS_WG = 66 * MiB + 512 * 1024;
constexpr size_t WS_WIN1 = 68 * MiB, WS_WOUT1 = 76 * MiB, WS_MGU = 78 * MiB, WS_MDN = 122 * MiB;
constexpr size_t WS_Z = 146 * MiB;
constexpr size_t WS_A1 = 418 * MiB;
constexpr size_t WS_END = 486 * MiB;
constexpr size_t ZOFF_F2 = 192 * MiB, ZOFF_FE = 96 * MiB;
constexpr int CW_BAR = 4096;

constexpr int RING_BYTES = 131072;
constexpr int LDSCTL_OFF = RING_BYTES, MISC_OFF = LDSCTL_OFF + 320;
constexpr int LDS_BYTES = 147456;

#define GAS __attribute__((address_space(1)))
#define LAS __attribute__((address_space(3)))
typedef unsigned short bf16;
typedef unsigned v4u __attribute__((ext_vector_type(4)));
typedef unsigned v2u __attribute__((ext_vector_type(2)));
typedef float f32x4 __attribute__((ext_vector_type(4)));
typedef float f32x2 __attribute__((ext_vector_type(2)));
typedef GAS unsigned gu32;
#define LDS_WAIT() asm volatile("s_waitcnt lgkmcnt(0)" ::: "memory")
#define VM_WAIT() asm volatile("s_waitcnt vmcnt(0)" ::: "memory")
__device__ __forceinline__ unsigned f2bf(float f) { unsigned u = __builtin_bit_cast(unsigned, f); return (u + 0x7fffu + ((u >> 16) & 1u)) >> 16; }
__device__ __forceinline__ unsigned pk2(float lo, float hi) { return pg8::cvt_pk_bf16(lo, hi); }
__device__ __forceinline__ float bf_lo(unsigned w) { return __builtin_bit_cast(float, w << 16); }
__device__ __forceinline__ float bf_hi(unsigned w) { return __builtin_bit_cast(float, w & 0xffff0000u); }
__device__ __forceinline__ float bf1(bf16 b) { return __builtin_bit_cast(float, ((unsigned)b) << 16); }
__device__ __forceinline__ float sigmoidf_(float x) { return 1.0f / (1.0f + __expf(-x)); }
__device__ __forceinline__ float wave_sum(float v) {
#pragma unroll
    for (int o = 1; o < 64; o <<= 1) v += __shfl_xor(v, o);
    return v;
}
#define XB_TMO      128
#define XB_XCNT(j)  (256  + 64 * (j))
#define XB_XSUB(j)  (1280 + 64 * (j))
#define XB_XGEN(j)  (2304 + 64 * (j))
#define XB_TOP      3328
#define XB_TOPGEN   3392
#define XCD_BAR_WORDS 3456
#define XB_SPIN_CAP (1u << 18)

__device__ __forceinline__ unsigned xb_ld(unsigned* p)              { return __hip_atomic_load(p, __ATOMIC_RELAXED, __HIP_MEMORY_SCOPE_AGENT); }
__device__ __forceinline__ unsigned xb_add(unsigned* p, unsigned v) { return __hip_atomic_fetch_add(p, v, __ATOMIC_RELAXED, __HIP_MEMORY_SCOPE_AGENT); }
__device__ __forceinline__ unsigned xb_xcc_id() { return (unsigned)__builtin_amdgcn_s_getreg((3 << 11) | 20) & 0xFu; }
#define XB_SPIN(cond, bar) do { unsigned _sp = 0; while (cond) { __builtin_amdgcn_s_sleep(1); \
    if ((++_sp & 255u) == 0u) { if (xb_ld(&(bar)[XB_TMO])) break; if (_sp > XB_SPIN_CAP) { atomicAdd(&(bar)[XB_TMO], 1u); break; } } } } while (0)

struct XcdBarrier {
    unsigned* bar; unsigned x;
    volatile LAS unsigned* st;
};

__device__ __forceinline__ XcdBarrier xcd_barrier_post(unsigned* bar, volatile LAS unsigned* st) {
    XcdBarrier b; b.bar = bar; b.x = xb_xcc_id(); b.st = st;
    if (threadIdx.x == 0) (void)xb_add(&bar[XB_XCNT(b.x)], 1u);
    return b;
}
__device__ __forceinline__ void xcd_barrier_complete(unsigned* bar, unsigned x, unsigned& nloc, unsigned& nx) {
    const unsigned G = gridDim.x * gridDim.y * gridDim.z;
    unsigned sum, cnt, mine, sp = 0u;
    for (;;) {
        sum = 0u; cnt = 0u; mine = 0u;
#pragma unroll
        for (unsigned j = 0; j < 16; ++j) { const unsigned c = xb_ld(&bar[XB_XCNT(j)]); sum += c; cnt += (c > 0u) ? 1u : 0u; mine = (j == x) ? c : mine; }
        if (sum == G) break;
        __builtin_amdgcn_s_sleep(1);
        if ((++sp & 255u) == 0u) { if (xb_ld(&bar[XB_TMO])) break; if (sp > XB_SPIN_CAP) { atomicAdd(&bar[XB_TMO], 1u); break; } }
    }
    nloc = mine > 0u ? mine : 1u; nx = cnt > 0u ? cnt : 1u;
}

__device__ __forceinline__ void xcd_barrier(const XcdBarrier& b) {
    asm volatile("s_waitcnt vmcnt(0)" ::: "memory");
    __syncthreads();
    if (threadIdx.x == 0) {
        unsigned* bar = b.bar;
        __builtin_amdgcn_s_waitcnt(0);
        unsigned nloc = b.st[0], nx = b.st[1];
        if (nloc == 0u) { xcd_barrier_complete(bar, b.x, nloc, nx); b.st[0] = nloc; b.st[1] = nx; }
        const unsigned old = xb_add(&bar[XB_XSUB(b.x)], 1u);
        const unsigned gen = old / nloc;
        if (old + 1u == (gen + 1u) * nloc) {
            __builtin_amdgcn_fence(__ATOMIC_RELEASE, "agent");
            asm volatile("s_waitcnt vmcnt(0)" ::: "memory");
            const unsigned og = xb_add(&bar[XB_TOP], 1u);
            const unsigned tg = og / nx;
            if (og + 1u == (tg + 1u) * nx) xb_add(&bar[XB_TOPGEN], 1u);
            else XB_SPIN(xb_ld(&bar[XB_TOPGEN]) == tg, bar);
            __builtin_amdgcn_fence(__ATOMIC_ACQUIRE, "agent");
            xb_add(&bar[XB_XGEN(b.x)], 1u);
            asm volatile("s_waitcnt vmcnt(0)" ::: "memory");
        } else {
            XB_SPIN(xb_ld(&bar[XB_XGEN(b.x)]) == gen, bar);
            __builtin_amdgcn_fence(__ATOMIC_ACQUIRE, "agent");
            asm volatile("s_waitcnt vmcnt(0)" ::: "memory");
        }
    }
    __syncthreads();
}
struct Args { const float* in[22]; float* out; unsigned char* ws; int code, layer, expert, single; };
enum { IN_X = 0, IN_C, IN_CTX, IN_CCTX, IN_WADA, IN_BADA, IN_WIN, IN_CONVW, IN_CONVB, IN_HLB, IN_GBIAS, IN_HGNORM, IN_MLNORM, IN_WOUT, IN_LNG, IN_LNB,
       IN_FGU, IN_FDN, IN_RW, IN_RB, IN_MGU, IN_MDN };
enum { PH_P0 = 0, PH_P1, PH_INPROJ, PH_SCAN_A, PH_SCAN_B, PH_OUTPROJ, PH_RESLN1, PH_FFNUP, PH_FFNDN, PH_RESLN2, PH_MOEUP, PH_MOEDN, PH_MOEACC, PH_FINAL };
struct Frame {
    LAS unsigned char* lds;
    int tid, lane, wave, bid, G;
    const Args* a;
    unsigned char* ws;
};
__device__ __forceinline__ Frame phase_frame(const Frame& F0) {
    Frame F = F0; int t = F0.tid, b = F0.bid; unsigned long long w = (unsigned long long)F0.ws;
    asm volatile("" : "+v"(t)); asm volatile("" : "+s"(b)); asm volatile("" : "+s"(w));
    F.tid = t; F.lane = t & 63; F.wave = __builtin_amdgcn_readfirstlane(t >> 6); F.bid = b; F.ws = (unsigned char*)w; return F;
}

__device__ __forceinline__ void transpose_item(const float* W, int ldn, int k0, int src_col0, bf16* WT, int ldk, int dst_row0, LAS float* scr, int lane) {
#pragma unroll 8
    for (int i = 0; i < 32; ++i) { const int kk = 2 * i + (lane >> 5); scr[kk * 33 + (lane & 31)] = W[(size_t)(k0 + kk) * ldn + src_col0 + (lane & 31)]; }
    LDS_WAIT(); asm volatile("" ::: "memory");
    const int c = lane & 7;
#pragma unroll
    for (int j = 0; j < 4; ++j) { const int n = (lane >> 3) + 8 * j; const LAS float* s = scr + (8 * c) * 33 + n;
        v4u o; o.x = pk2(s[0 * 33], s[1 * 33]); o.y = pk2(s[2 * 33], s[3 * 33]); o.z = pk2(s[4 * 33], s[5 * 33]); o.w = pk2(s[6 * 33], s[7 * 33]);
        *(GAS v4u*)(WT + (size_t)(dst_row0 + n) * ldk + k0 + 8 * c) = o; }
    LDS_WAIT(); asm volatile("" ::: "memory");
}
constexpr int T_WIN = 16 * 128, T_WOUT = 16 * 32, T_FGU = 16 * 176, T_FDN = 44 * 32, T_MGU = 8 * 16 * 88, T_MDN = 8 * 22 * 32;
constexpr int T_TOTAL = 2 * T_WIN + 2 * T_WOUT + T_FGU + T_FDN + T_MGU + T_MDN;
__device__ __forceinline__ void weight_item(const Frame& F, int r, LAS float* scr) {
    const Args& A = *F.a; unsigned char* ws = F.ws;
#pragma unroll 1
    for (int l = 0; l < 2; ++l) {
        if (r < T_WIN) { const int nb = r % 128, kb = r / 128;
            transpose_item(A.in[IN_WIN] + (size_t)l * 1024 * PROJ, PROJ, 64 * kb, 32 * nb + (nb >= 112 ? 16 : 0), (bf16*)(ws + (l ? WS_WIN1 : WS_WIN0)), 1024, 32 * nb, scr, F.lane); return; }
        r -= T_WIN;
        if (r < T_WOUT) { const int nb = r % 32, kb = r / 32;
            transpose_item(A.in[IN_WOUT] + (size_t)l * 1024 * 1024, 1024, 64 * kb, 32 * nb, (bf16*)(ws + (l ? WS_WOUT1 : WS_WOUT0)), 1024, 32 * nb, scr, F.lane); return; }
        r -= T_WOUT;
        if (l == 0) {
            if (r < T_FGU) { const int nb = r % 176, kb = r / 176, pn = nb >> 3, bj = (nb >> 2) & 1, jb = nb & 3;
                transpose_item(A.in[IN_FGU], 2 * DFF, 64 * kb, bj * DFF + 128 * pn + 32 * jb, (bf16*)(ws + WS_FGU), 1024, 32 * nb, scr, F.lane); return; }
            r -= T_FGU;
            if (r < T_FDN) { const int nb = r % 32, kb = r / 32;
                transpose_item(A.in[IN_FDN], 1024, 64 * kb, 32 * nb, (bf16*)(ws + WS_FDN), DFF, 32 * nb, scr, F.lane); return; }
            r -= T_FDN;
        } else {
            if (r < T_MGU) { const int e = r / 1408, rr = r % 1408, nb = rr % 88, kb = rr / 88, pn = nb >> 3, bj = (nb >> 2) & 1, jb = nb & 3;
                transpose_item(A.in[IN_MGU] + (size_t)e * 1024 * 2 * DEXP, 2 * DEXP, 64 * kb, bj * DEXP + 128 * pn + 32 * jb, (bf16*)(ws + WS_MGU) + (size_t)e * 2 * DEXP * 1024, 1024, 32 * nb, scr, F.lane); return; }
            r -= T_MGU;
            if (r < T_MDN) { const int e = r / 704, rr = r % 704, nb = rr % 32, kb = rr / 32;
                transpose_item(A.in[IN_MDN] + (size_t)e * DEXP * 1024, 1024, 64 * kb, 32 * nb, (bf16*)(ws + WS_MDN) + (size_t)e * 1024 * DEXP, DEXP, 32 * nb, scr, F.lane); return; }
        }
    }
}
__device__ __forceinline__ void phase_p0(const Frame& F) {
    const Args& A = *F.a; unsigned char* ws = F.ws;
    if (F.bid < 192) {
        LAS float* cond = (LAS float*)F.lds;
        LAS float* red = (LAS float*)(F.lds + 36864);
        for (int i = F.tid; i < 9 * 1024; i += NTHREADS) { const int r = i >> 10, k = i & 1023; const float c = r < 8 ? A.in[IN_C][r * 1024 + k] : A.in[IN_CCTX][k]; cond[i] = c * sigmoidf_(c); }
        __syncthreads();
        for (int it = F.bid; it < 192; it += F.G) {
            const int l = it / 96, col0 = (it % 96) * 64, c = F.tid & 63, kg = F.tid >> 6;
            float acc[9];
#pragma unroll
            for (int r = 0; r < 9; ++r) acc[r] = 0.f;
            const float* wp = A.in[IN_WADA] + ((size_t)l * 1024 + kg * 128) * 6144 + col0 + c;
#pragma unroll 4
            for (int k = 0; k < 128; ++k) { const float w = wp[(size_t)k * 6144];
#pragma unroll
                for (int r = 0; r < 9; ++r) acc[r] += cond[r * 1024 + kg * 128 + k] * w; }
#pragma unroll
            for (int r = 0; r < 9; ++r) red[(kg * 9 + r) * 64 + c] = acc[r];
            __syncthreads();
            for (int o = F.tid; o < 576; o += NTHREADS) { const int r = o >> 6, cc = o & 63; float s = A.in[IN_BADA][l * 6144 + col0 + cc];
#pragma unroll
                for (int g = 0; g < 8; ++g) s += red[(g * 9 + r) * 64 + cc];
                ((float*)(ws + WS_MODF))[(l * 9 + r) * 6144 + col0 + cc] = s; }
            __syncthreads();
        }
    }
    { const int gid = F.bid * NTHREADS + F.tid;
      if (gid < 2048) { const int l = gid >> 10, dir = (gid >> 9) & 1, i = gid & 511; float v = 0.f;
          if (l == 1) { const float h0 = A.in[IN_HLB][(0 * 2 + dir) * 512 + i], h1 = A.in[IN_HLB][(1 * 2 + dir) * 512 + i]; v = 1.0f / (1.0f + __expf(h0 - h1)); }
          ((float*)(ws + WS_LBV))[gid] = v; }
      else if (gid < 2048 + 32768) { const int idx = gid - 2048, l = idx >> 14, g = (idx >> 10) & 15, k = idx & 1023;
          ((bf16*)(ws + WS_WG))[idx] = (bf16)f2bf(A.in[IN_WIN][((size_t)l * 1024 + k) * PROJ + 3584 + g]); } }
    __syncthreads();
    { LAS float* scr = (LAS float*)(F.lds + F.wave * 16384);
      const int gw = F.bid * NWAVES + F.wave, NGW = F.G * NWAVES;
      for (int it = gw; it < T_TOTAL; it += NGW) weight_item(F, it, scr); }
}

struct RowVecs { f32x4 gate[4], lng[4], lnb[4], sc[4], sh[4]; };
template <bool HAS_BR, bool HAS_LN, bool HAS_XOUT, bool HAS_HX, int MOE>
__device__ __forceinline__ void row_one(const Frame& F, const RowVecs& V, const float* xrow, const bf16* frow, float* orow, bf16* hrow, int rowid, const LAS float* rw) {
    const GAS f32x4* xr = (const GAS f32x4*)xrow + F.lane;
    f32x4 v[4];
#pragma unroll
    for (int j = 0; j < 4; ++j) v[j] = xr[64 * j];
    if (HAS_BR) {
        const GAS v2u* fr = (const GAS v2u*)frow + F.lane;
#pragma unroll
        for (int j = 0; j < 4; ++j) { const v2u w = fr[64 * j]; const f32x4 f = (f32x4){bf_lo(w.x), bf_hi(w.x), bf_lo(w.y), bf_hi(w.y)}; v[j] = v[j] * DN_ALPHA + V.gate[j] * f; }
    }
    if (HAS_LN) {
        float s = 0.f;
#pragma unroll
        for (int j = 0; j < 4; ++j) s += (v[j].x + v[j].y) + (v[j].z + v[j].w);
        const float mean = wave_sum(s) * (1.f / DM); float s2 = 0.f;
#pragma unroll
        for (int j = 0; j < 4; ++j) { v[j] = v[j] - mean; s2 += (v[j].x * v[j].x + v[j].y * v[j].y) + (v[j].z * v[j].z + v[j].w * v[j].w); }
        const float rstd = 1.0f / sqrtf(wave_sum(s2) * (1.f / DM) + LN_EPS);
#pragma unroll
        for (int j = 0; j < 4; ++j) v[j] = v[j] * rstd * V.lng[j] + V.lnb[j];
    }
    if (HAS_XOUT) { GAS f32x4* o = (GAS f32x4*)orow + F.lane;
#pragma unroll
        for (int j = 0; j < 4; ++j) o[64 * j] = v[j]; }
    if (HAS_HX) {
        f32x4 h[4];
#pragma unroll
        for (int j = 0; j < 4; ++j) h[j] = v[j] * (1.0f + V.sc[j]) + V.sh[j];
        GAS v2u* o = (GAS v2u*)hrow + F.lane;
#pragma unroll
        for (int j = 0; j < 4; ++j) { v2u w; w.x = pk2(h[j].x, h[j].y); w.y = pk2(h[j].z, h[j].w); o[64 * j] = w; }
        if (MOE == 1) {
            float lg[8];
#pragma unroll
            for (int e = 0; e < 8; ++e) lg[e] = 0.f;
#pragma unroll
            for (int j = 0; j < 4; ++j) { asm volatile("" ::: "memory");
#pragma unroll
                for (int q = 0; q < 4; ++q) { const int col = 4 * F.lane + 256 * j + q; const f32x4 w0 = *(const LAS f32x4*)(rw + col * 8), w1 = *(const LAS f32x4*)(rw + col * 8 + 4); const float hv = h[j][q];
                    lg[0] += hv * w0.x; lg[1] += hv * w0.y; lg[2] += hv * w0.z; lg[3] += hv * w0.w; lg[4] += hv * w1.x; lg[5] += hv * w1.y; lg[6] += hv * w1.z; lg[7] += hv * w1.w; } }
#pragma unroll
            for (int e = 0; e < 8; ++e) lg[e] = wave_sum(lg[e]) + F.a->in[IN_RB][e];
            int e1 = 0; float v1 = lg[0];
#pragma unroll
            for (int e = 1; e < 8; ++e) if (lg[e] > v1) { v1 = lg[e]; e1 = e; }
            int e2 = -1; float v2 = -3.0e38f;
#pragma unroll
            for (int e = 0; e < 8; ++e) if (e != e1 && lg[e] > v2) { v2 = lg[e]; e2 = e; }
            const float p1 = 1.0f / (1.0f + __expf(v2 - v1));
            if (F.lane == 0) { ((int*)(F.ws + WS_TOPE))[rowid] = e1 | (e2 << 8); ((f32x2*)(F.ws + WS_TOPP))[rowid] = (f32x2){p1, 1.0f - p1}; }
        }
    }
}
template <bool HAS_BR, bool HAS_LN, bool HAS_XOUT, bool HAS_HX, int MOE>
__device__ __forceinline__ void row_phase(const Frame& F, int l, int sub, const float* xlat, const float* xctx, const bf16* fbr, float* olat, float* octx, bf16* hx, int hl, bool do_ctx) {
    const Args& A = *F.a; const float* modf = (const float*)(F.ws + WS_MODF);
    const LAS float* rw = (const LAS float*)F.lds;
    if (MOE == 1) { for (int i = F.tid; i < 8192; i += NTHREADS) ((LAS float*)F.lds)[i] = A.in[IN_RW][i]; __syncthreads(); }
    const int gidx = sub ? 5 : 2, shidx = sub ? 0 : 3;
#pragma unroll 1
    for (int seg = 0; seg < 2; ++seg) {
        if (seg == 1 && !do_ctx) break;
        const int r = seg ? 8 : (F.bid >> 5);
        RowVecs V;
#pragma unroll
        for (int j = 0; j < 4; ++j) { const int c = 4 * F.lane + 256 * j;
            V.gate[j] = HAS_BR ? *(const f32x4*)(modf + (l * 9 + r) * 6144 + gidx * 1024 + c) : (f32x4){0.f, 0.f, 0.f, 0.f};
            V.lng[j] = HAS_LN ? *(const f32x4*)(A.in[IN_LNG] + (l * 2 + sub) * 1024 + c) : (f32x4){0.f, 0.f, 0.f, 0.f};
            V.lnb[j] = HAS_LN ? *(const f32x4*)(A.in[IN_LNB] + (l * 2 + sub) * 1024 + c) : (f32x4){0.f, 0.f, 0.f, 0.f};
            V.sh[j] = HAS_HX ? *(const f32x4*)(modf + (hl * 9 + r) * 6144 + shidx * 1024 + c) : (f32x4){0.f, 0.f, 0.f, 0.f};
            V.sc[j] = HAS_HX ? *(const f32x4*)(modf + (hl * 9 + r) * 6144 + (shidx + 1) * 1024 + c) : (f32x4){0.f, 0.f, 0.f, 0.f}; }
        if (seg == 0) {
#pragma unroll 1
            for (int i = 0; i < 16; ++i) { const int row = F.bid * 128 + F.wave * 16 + i;
                row_one<HAS_BR, HAS_LN, HAS_XOUT, HAS_HX, MOE>(F, V, xlat + (size_t)row * DM, fbr + (size_t)row * DM, olat + (size_t)row * DM, hx + (size_t)row * DM, row, rw); }
        } else {
            const int cr = F.bid * 8 + F.wave, row = M_LAT + cr;
            row_one<HAS_BR, HAS_LN, HAS_XOUT, HAS_HX, 0>(F, V, xctx + (size_t)cr * DM, fbr + (size_t)row * DM, octx + (size_t)cr * DM, hx + (size_t)row * DM, row, rw);
        }
    }
}

__device__ __forceinline__ void gates_naive(const Frame& F, int l) {
    const bf16* hx = (const bf16*)(F.ws + WS_A1); const bf16* wg = (const bf16*)(F.ws + WS_WG) + (size_t)l * 16 * 1024;
    float* gates = (float*)(F.ws + WS_GATES); const float* gb = F.a->in[IN_GBIAS] + l * 16;
    for (int idx = F.bid * NTHREADS + F.tid; idx < M_ALL * 16; idx += F.G * NTHREADS) {
        const int row = idx >> 4, g = idx & 15; const GAS v4u* hp = (const GAS v4u*)(hx + (size_t)row * DM); const GAS v4u* wp = (const GAS v4u*)(wg + g * 1024);
        float acc = 0.f;
#pragma unroll 4
        for (int k = 0; k < 128; ++k) { const v4u a = hp[k], b = wp[k];
            acc += bf_lo(a.x) * bf_lo(b.x) + bf_hi(a.x) * bf_hi(b.x) + bf_lo(a.y) * bf_lo(b.y) + bf_hi(a.y) * bf_hi(b.y) + bf_lo(a.z) * bf_lo(b.z) + bf_hi(a.z) * bf_hi(b.z) + bf_lo(a.w) * bf_lo(b.w) + bf_hi(a.w) * bf_hi(b.w); }
        float v = acc + gb[g];
        if ((g >> 2) & 1) v = fminf(v, 0.f) - log1pf(__expf(-fabsf(v)));
        gates[idx] = v;
    }
}

__device__ __forceinline__ int chain_row(int b, int dir, int s, int i, bool& is_ctx, int& tglob) {
    const int t = dir ? 63 - i : i;
    if (s < 4) { is_ctx = true; const int ch = dir ? 3 - s : s; tglob = ch * 64 + t; return M_LAT + b * CTXL + ch * 64 + t; }
    is_ctx = false; const int ch = dir ? 67 - s : s - 4; tglob = t; return b * SEQ + ch * 64 + t;
}
__device__ __forceinline__ void scan_out(const Frame& F, int dir, int row, int ycol, const float (&o)[4], const float* normw, const bf16* zg) {
    bf16* y = (bf16*)(F.ws + WS_A1) + (size_t)row * DM + ycol;
    if (dir == 1) { v2u w; w.x = pk2(o[0], o[1]); w.y = pk2(o[2], o[3]); *(GAS v2u*)y = w; return; }
    const v2u rw = *(const GAS v2u*)y; float t[4] = {o[0] + bf_lo(rw.x), o[1] + bf_hi(rw.x), o[2] + bf_lo(rw.y), o[3] + bf_hi(rw.y)};
    float ss = t[0] * t[0] + t[1] * t[1] + t[2] * t[2] + t[3] * t[3];
#pragma unroll
    for (int m = 1; m < 32; m <<= 1) ss += __shfl_xor(ss, m);
    const float rr = 1.0f / sqrtf(ss * (1.f / 128.f) + RMS_EPS);
    const v2u gw = *(const GAS v2u*)zg; const float g[4] = {bf_lo(gw.x), bf_hi(gw.x), bf_lo(gw.y), bf_hi(gw.y)};
    v2u w; w.x = pk2(t[0] * rr * normw[0] * g[0], t[1] * rr * normw[1] * g[1]); w.y = pk2(t[2] * rr * normw[2] * g[2], t[3] * rr * normw[3] * g[3]); *(GAS v2u*)y = w;
}
__device__ __forceinline__ void naive_hgrn(const Frame& F, int l, int b, int h) {
    const bf16* z = (const bf16*)(F.ws + WS_Z);
    LAS float* Fx = (LAS float*)F.lds; LAS float* Qx = Fx + 8192; LAS float* Vx = Qx + 8192; LAS float* opart = Vx + 8192;
    const int v = F.tid & 127, dg = F.tid >> 7, tt = F.tid >> 5, vq = F.tid & 31;
    float nw[4];
#pragma unroll
    for (int e = 0; e < 4; ++e) nw[e] = F.a->in[IN_HGNORM][(l * 4 + h) * 128 + 4 * vq + e];
#pragma unroll 1
    for (int dir = 1; dir >= 0; --dir) {
        float S[32];
#pragma unroll
        for (int d = 0; d < 32; ++d) S[d] = 0.f;
#pragma unroll 1
        for (int s = 0; s < 68; ++s) {
            for (int idx = F.tid; idx < 1024; idx += NTHREADS) { const int i = idx >> 4, ch = idx & 15; bool ic; int tg; const int row = chain_row(b, dir, s, i, ic, tg);
                const bf16* zr = z + (size_t)row * ZLD + h * 128 + ch * 8;
                const v4u q = *(const GAS v4u*)(zr + ZC_HQ), f = *(const GAS v4u*)(zr + (dir ? ZC_HF1 : ZC_HF0)), vv = *(const GAS v4u*)(zr + ZC_HI);
                LAS float* qd = Qx + i * 128 + ch * 8; LAS float* fd = Fx + i * 128 + ch * 8; LAS float* vd = Vx + i * 128 + ch * 8;
                qd[0] = bf_lo(q.x); qd[1] = bf_hi(q.x); qd[2] = bf_lo(q.y); qd[3] = bf_hi(q.y); qd[4] = bf_lo(q.z); qd[5] = bf_hi(q.z); qd[6] = bf_lo(q.w); qd[7] = bf_hi(q.w);
                fd[0] = __expf(bf_lo(f.x)); fd[1] = __expf(bf_hi(f.x)); fd[2] = __expf(bf_lo(f.y)); fd[3] = __expf(bf_hi(f.y)); fd[4] = __expf(bf_lo(f.z)); fd[5] = __expf(bf_hi(f.z)); fd[6] = __expf(bf_lo(f.w)); fd[7] = __expf(bf_hi(f.w));
                vd[0] = bf_lo(vv.x); vd[1] = bf_hi(vv.x); vd[2] = bf_lo(vv.y); vd[3] = bf_hi(vv.y); vd[4] = bf_lo(vv.z); vd[5] = bf_hi(vv.z); vd[6] = bf_lo(vv.w); vd[7] = bf_hi(vv.w); }
            __syncthreads();
#pragma unroll 1
            for (int grp = 0; grp < 4; ++grp) {
#pragma unroll 1
                for (int t2 = 0; t2 < 16; ++t2) { const int i = grp * 16 + t2; const float vv = Vx[i * 128 + v]; float po = 0.f;
#pragma unroll
                    for (int d4 = 0; d4 < 8; ++d4) { const f32x4 f = *(const LAS f32x4*)(Fx + i * 128 + dg * 32 + d4 * 4), q = *(const LAS f32x4*)(Qx + i * 128 + dg * 32 + d4 * 4);
#pragma unroll
                        for (int e = 0; e < 4; ++e) { const int d = d4 * 4 + e; S[d] = f[e] * S[d] + (1.0f - f[e]) * vv; po += S[d] * q[e]; } }
                    opart[(t2 * 4 + dg) * 128 + v] = po; }
                __syncthreads();
                { const int i = grp * 16 + tt; bool ic; int tg; const int row = chain_row(b, dir, s, i, ic, tg); float o[4];
#pragma unroll
                  for (int e = 0; e < 4; ++e) o[e] = opart[(tt * 4 + 0) * 128 + 4 * vq + e] + opart[(tt * 4 + 1) * 128 + 4 * vq + e] + opart[(tt * 4 + 2) * 128 + 4 * vq + e] + opart[(tt * 4 + 3) * 128 + 4 * vq + e];
                  scan_out(F, dir, row, h * 128 + 4 * vq, o, nw, z + (size_t)row * ZLD + ZC_HG + h * 128 + 4 * vq); }
                __syncthreads();
            }
        }
        VM_WAIT(); __syncthreads();
    }
}
__device__ __forceinline__ void naive_mlstm(const Frame& F, int l, int b, int h) {
    const bf16* z = (const bf16*)(F.ws + WS_Z); const float* gates = (const float*)(F.ws + WS_GATES);
    LAS float* Qc = (LAS float*)F.lds; LAS float* Kc = Qc + 4096; LAS float* Vx = Kc + 4096; LAS float* opart = Vx + 8192; LAS float* dpart = opart + 8192; LAS float* gi = dpart + 64; LAS float* gf = gi + 64;
    const int v = F.tid & 127, dg = F.tid >> 7, tt = F.tid >> 5, vq = F.tid & 31;
    const float* cw = F.a->in[IN_CONVW] + l * 3 * 512; const float* cb = F.a->in[IN_CONVB] + l * 512;
    float nw[4];
#pragma unroll
    for (int e = 0; e < 4; ++e) nw[e] = F.a->in[IN_MLNORM][(l * 4 + h) * 128 + 4 * vq + e];
#pragma unroll 1
    for (int dir = 1; dir >= 0; --dir) {
        float C[16], n[16];
#pragma unroll
        for (int d = 0; d < 16; ++d) { C[d] = 0.f; n[d] = 0.f; }
#pragma unroll 1
        for (int s = 0; s < 68; ++s) {
            for (int idx = F.tid; idx < 8192; idx += NTHREADS) { const int i = idx >> 7, c = idx & 127; bool ic; int tg; const int row = chain_row(b, dir, s, i, ic, tg);
                const int chan = c < 64 ? h * 64 + c : 256 + h * 64 + (c - 64);
                const bool hp = tg > 0, hn = ic ? (tg < CTXL - 1) : (tg < 63);
                const bf16* zp = z + (size_t)row * ZLD + ZC_MQ + chan;
                const float u0 = hp ? bf1(zp[-ZLD]) : 0.f, u1 = bf1(zp[0]), u2 = hn ? bf1(zp[ZLD]) : 0.f;
                const float val = cb[chan] + cw[chan] * u0 + cw[512 + chan] * u1 + cw[1024 + chan] * u2, sv = val * sigmoidf_(val);
                if (c < 64) Qc[i * 64 + c] = sv * 0.125f; else Kc[i * 64 + c - 64] = sv; }
            for (int idx = F.tid; idx < 1024; idx += NTHREADS) { const int i = idx >> 4, ch = idx & 15; bool ic; int tg; const int row = chain_row(b, dir, s, i, ic, tg);
                const v4u vv = *(const GAS v4u*)(z + (size_t)row * ZLD + ZC_MV + h * 128 + ch * 8); LAS float* vd = Vx + i * 128 + ch * 8;
                vd[0] = bf_lo(vv.x); vd[1] = bf_hi(vv.x); vd[2] = bf_lo(vv.y); vd[3] = bf_hi(vv.y); vd[4] = bf_lo(vv.z); vd[5] = bf_hi(vv.z); vd[6] = bf_lo(vv.w); vd[7] = bf_hi(vv.w); }
            if (F.tid < 64) { bool ic; int tg; const int row = chain_row(b, dir, s, F.tid, ic, tg); gi[F.tid] = __expf(gates[(size_t)row * 16 + dir * 8 + h]); gf[F.tid] = __expf(gates[(size_t)row * 16 + dir * 8 + 4 + h]); }
            __syncthreads();
#pragma unroll 1
            for (int grp = 0; grp < 4; ++grp) {
#pragma unroll 1
                for (int t2 = 0; t2 < 16; ++t2) { const int i = grp * 16 + t2; const float vv = Vx[i * 128 + v], ig = gi[i], fg = gf[i]; float po = 0.f, pd = 0.f;
#pragma unroll
                    for (int d4 = 0; d4 < 4; ++d4) { const f32x4 k4 = *(const LAS f32x4*)(Kc + i * 64 + dg * 16 + d4 * 4), q4 = *(const LAS f32x4*)(Qc + i * 64 + dg * 16 + d4 * 4);
#pragma unroll
                        for (int e = 0; e < 4; ++e) { const int d = d4 * 4 + e; const float kk = k4[e] * ig; C[d] = fg * C[d] + kk * vv; n[d] = fg * n[d] + kk; po += C[d] * q4[e]; pd += n[d] * q4[e]; } }
                    opart[(t2 * 4 + dg) * 128 + v] = po; if (v == 0) dpart[t2 * 4 + dg] = pd; }
                __syncthreads();
                { const int i = grp * 16 + tt; bool ic; int tg; const int row = chain_row(b, dir, s, i, ic, tg); float o[4];
                  const float den = dpart[tt * 4] + dpart[tt * 4 + 1] + dpart[tt * 4 + 2] + dpart[tt * 4 + 3], inv = 1.0f / fmaxf(fabsf(den), 1.0f);
#pragma unroll
                  for (int e = 0; e < 4; ++e) o[e] = (opart[(tt * 4 + 0) * 128 + 4 * vq + e] + opart[(tt * 4 + 1) * 128 + 4 * vq + e] + opart[(tt * 4 + 2) * 128 + 4 * vq + e] + opart[(tt * 4 + 3) * 128 + 4 * vq + e]) * inv;
                  scan_out(F, dir, row, 512 + h * 128 + 4 * vq, o, nw, z + (size_t)row * ZLD + ZC_MO + h * 128 + 4 * vq); }
                __syncthreads();
            }
        }
        VM_WAIT(); __syncthreads();
    }
}
#ifndef EN_MASK
#define EN_MASK 0xffff
#endif
#define EN(c) (((EN_MASK) >> (c)) & 1)
__global__ void __launch_bounds__(NTHREADS, 2) hyb_fwd(Args args) {
    extern __shared__ __attribute__((aligned(16))) unsigned char lds_raw[];
    Frame F0;
    F0.lds = (LAS unsigned char*)lds_raw;
    F0.tid = threadIdx.x; F0.lane = F0.tid & 63; F0.wave = __builtin_amdgcn_readfirstlane(F0.tid >> 6);
    F0.bid = blockIdx.x; F0.G = gridDim.x; F0.a = &args; F0.ws = args.ws;
    volatile LAS unsigned* MISC = (volatile LAS unsigned*)(F0.lds + MISC_OFF);
    for (int u = F0.tid; u < (LDS_BYTES - LDSCTL_OFF) / 4; u += NTHREADS) ((LAS unsigned*)(F0.lds + LDSCTL_OFF))[u] = 0u;
    __syncthreads();
    const bool single = args.single != 0;
    XcdBarrier bar; bar.bar = (unsigned*)(args.ws + WS_CTL) + CW_BAR; bar.x = 0; bar.st = nullptr;
    if (single) bar = xcd_barrier_post((unsigned*)(args.ws + WS_CTL) + CW_BAR, MISC + 8);
#define RUN(c, l) (single || (args.code == (c) && args.layer == (l)))
#define GRID_BAR() do { if (single) xcd_barrier(bar); } while (0)

#define PHASE_LOCALS const Frame F = phase_frame(F0); unsigned char* const ws = F.ws; bf16* const A1 = (bf16*)(ws + WS_A1); bf16* const Z = (bf16*)(ws + WS_Z); float* const XC = (float*)(ws + WS_XC); \
    const float* const x_in = args.in[IN_X]; const float* const ctx_in = args.in[IN_CTX]; (void)A1; (void)Z; (void)XC; (void)x_in; (void)ctx_in;

    if (EN(PH_P0) && RUN(PH_P0, 0)) { PHASE_LOCALS phase_p0(F); GRID_BAR(); }
    if (EN(PH_P1) && RUN(PH_P1, 0)) { PHASE_LOCALS row_phase<false, false, false, true, 0>(F, 0, 1, x_in, ctx_in, A1, args.out, XC, A1, 0, true); GRID_BAR(); }

#pragma unroll 1
    for (int l = 0; l < DEPTH; ++l) {
        const bool last = (l == DEPTH - 1);
        if (EN(PH_INPROJ) && RUN(PH_INPROJ, l)) { PHASE_LOCALS
            gates_naive(F, l);
            pg8::Gemm g{A1, (const bf16*)(ws + (l ? WS_WIN1 : WS_WIN0)), M_ALL, ZLD, DM}; pg8::StaticOrder S; S.init(M_ALL, ZLD, F.G, F.bid);
            pg8::EpiZ E{Z, (const float*)(ws + WS_LBV) + l * 1024};
            pg8::gemm_phase<pg8::EpiZ, pg8::StaticOrder, true, true>(F.lds, g, S, E);
            GRID_BAR();
        }
        if (EN(PH_SCAN_A) && RUN(PH_SCAN_A, l)) { PHASE_LOCALS
            if (F.bid < 64) { const int type = F.bid >> 5, bh = F.bid & 31, b = bh >> 2, h = bh & 3;
                if (type == 0) naive_hgrn(F, l, b, h); else naive_mlstm(F, l, b, h); }
            GRID_BAR();
        }
        if (EN(PH_OUTPROJ) && RUN(PH_OUTPROJ, l)) { PHASE_LOCALS
            const int M = last ? M_LAT : M_ALL;
            pg8::Gemm g{A1, (const bf16*)(ws + (l ? WS_WOUT1 : WS_WOUT0)), M, DM, DM}; pg8::StaticOrder S; S.init(M, DM, F.G, F.bid);
            pg8::EpiPlain E{Z, DM};
            pg8::gemm_phase<pg8::EpiPlain, pg8::StaticOrder, true, true>(F.lds, g, S, E);
            GRID_BAR();
        }
        if (EN(PH_RESLN1) && RUN(PH_RESLN1, l)) { PHASE_LOCALS
            if (l == 0) row_phase<true, true, true, true, 0>(F, l, 0, x_in, ctx_in, Z, args.out, XC, A1, l, true);
            else        row_phase<true, true, true, true, 1>(F, l, 0, args.out, XC, Z, args.out, XC, A1, l, false);
            GRID_BAR();
        }
        if (EN(PH_FFNUP) && (RUN(PH_FFNUP, l) || (!single && args.code == PH_MOEUP && args.layer == l))) { PHASE_LOCALS
            const bool moe = (l & 1) != 0; const int e = args.expert;
            const int M = moe ? M_LAT : M_ALL, N = moe ? 2 * DEXP : 2 * DFF;
            const bf16* Bt = moe ? (const bf16*)(ws + WS_MGU) + (size_t)e * 2 * DEXP * 1024 : (const bf16*)(ws + WS_FGU);
            pg8::Gemm g{A1, Bt, M, N, DM}; pg8::StaticOrder S; S.init(M, N, F.G, F.bid);
            pg8::EpiSwiGLU E{Z, moe ? DEXP : DFF, 1024};
            pg8::gemm_phase<pg8::EpiSwiGLU, pg8::StaticOrder, true, true>(F.lds, g, S, E);
            GRID_BAR();
        }
        if (EN(PH_FFNDN) && (RUN(PH_FFNDN, l) || (!single && args.code == PH_MOEDN && args.layer == l))) { PHASE_LOCALS
            const bool moe = (l & 1) != 0; const int e = args.expert;
            const int M = moe ? M_LAT : M_ALL, K = moe ? DEXP : DFF;
            const bf16* Bt = moe ? (const bf16*)(ws + WS_MDN) + (size_t)e * 1024 * DEXP : (const bf16*)(ws + WS_FDN);
            pg8::Gemm g{Z, Bt, M, DM, K}; pg8::StaticOrder S; S.init(M, DM, F.G, F.bid);
            pg8::EpiPlain E{(bf16*)(ws + WS_Z + (moe ? ZOFF_FE : ZOFF_F2)), DM};
            pg8::gemm_phase<pg8::EpiPlain, pg8::StaticOrder, true, true>(F.lds, g, S, E);
            GRID_BAR();
        }
        if (EN(PH_RESLN2) && l == 0 && RUN(PH_RESLN2, l)) { PHASE_LOCALS
            row_phase<true, true, true, true, 0>(F, l, 1, args.out, XC, (const bf16*)(ws + WS_Z + ZOFF_F2), args.out, XC, A1, l + 1, true);
            GRID_BAR();
        }
        if (EN(PH_MOEACC) && !single && args.code == PH_MOEACC && args.layer == l) { PHASE_LOCALS
            const int e = args.expert; const float* modf = (const float*)(ws + WS_MODF); const bf16* fe = (const bf16*)(ws + WS_Z + ZOFF_FE);
            const int r = F.bid >> 5;
            f32x4 gate[4];
#pragma unroll
            for (int j = 0; j < 4; ++j) gate[j] = *(const f32x4*)(modf + (l * 9 + r) * 6144 + 5 * 1024 + 4 * F.lane + 256 * j);
#pragma unroll 1
            for (int i = 0; i < 16; ++i) { const int row = F.bid * 128 + F.wave * 16 + i;
                GAS f32x4* xr = (GAS f32x4*)(args.out + (size_t)row * DM) + F.lane; const GAS v2u* fr = (const GAS v2u*)(fe + (size_t)row * DM) + F.lane;
                const int te = ((const int*)(ws + WS_TOPE))[row]; const f32x2 pp = ((const f32x2*)(ws + WS_TOPP))[row];
                const float p = ((te & 255) == e) ? pp.x : (((te >> 8) == e) ? pp.y : 0.f);
#pragma unroll
                for (int j = 0; j < 4; ++j) { f32x4 v = xr[64 * j]; if (e == 0) v = v * DN_ALPHA; const v2u w = fr[64 * j];
                    const f32x4 f = (f32x4){bf_lo(w.x), bf_hi(w.x), bf_lo(w.y), bf_hi(w.y)}; v = v + gate[j] * (f * p); xr[64 * j] = v; } }
        }
        if (EN(PH_FINAL) && !single && args.code == PH_FINAL && args.layer == l) { PHASE_LOCALS
            row_phase<false, true, true, false, 0>(F, l, 1, args.out, XC, Z, args.out, XC, A1, l, false);
        }
    }
#ifdef DBG_DUMP
    if (!single && args.code == 99) { PHASE_LOCALS
        const int sel = args.expert; const size_t n = (size_t)M_LAT * DM;
        for (size_t i = (size_t)F.bid * NTHREADS + F.tid; i < n; i += (size_t)F.G * NTHREADS) {
            const size_t r = i >> 10, c = i & 1023; float v = 0.f;
            if (sel == 0) v = ((const float*)(ws + WS_MODF))[i % 110592];
            else if (sel == 1 || sel == 7) v = bf1(A1[i]);
            else if (sel >= 2 && sel <= 5) v = bf1(Z[r * ZLD + (sel - 2) * 1024 + c]);
            else if (sel == 6) v = ((const float*)(ws + WS_GATES))[i % (M_ALL * 16)];
            else if (sel == 8) v = bf1(Z[i]);
            else if (sel == 9) v = bf1(((const bf16*)(ws + WS_WIN0))[i % (4096 * 1024)]);
            else if (sel == 11) v = bf1(A1[r * 1024 + (c & 511)]);
            else if (sel == 12) v = bf1(A1[r * 1024 + 512 + (c & 511)]);
            else if (sel == 13) v = bf1(Z[r * ZLD + 3072 + (c & 511)]);
            else if (sel == 14) v = bf1(Z[r * ZLD + 3584 + (c & 511)]);
            else if (sel == 15) { const float t = bf1(Z[r * ZLD + 3584 + (c & 511)]); v = (t > 1.001f || t < -0.001f || !(t == t)) ? 1000.f : 0.f; }
            else if (sel == 16) { const float t = bf1(Z[r * ZLD + 3072 + c]); v = (!(t == t) || fabsf(t) > 1e4f) ? 1000.f : 0.f; }
            else if (sel == 17) { const float t = bf1(Z[r * ZLD + c]); v = (!(t == t) || fabsf(t) > 1e4f) ? 1000.f : 0.f; }
            else if (sel == 18) { const float t = bf1(A1[i]); v = (!(t == t) || fabsf(t) > 1e4f) ? 1000.f : 0.f; }
            else if (sel == 19) { const float t = bf1(((const bf16*)(ws + WS_WIN0))[i % (4096 * 1024)]); v = (!(t == t) || fabsf(t) > 1e4f) ? 1000.f : 0.f; }
            else if (sel == 20) { const float t = bf1(Z[r * ZLD + (c & 511)]); v = (t < -0.29f) ? 1000.f : 0.f; }
            else if (sel == 21) { const float t = bf1(Z[r * ZLD + 512 + c]); v = (t > 0.001f) ? 1000.f : 0.f; }
            else if (sel == 22) { const float t = bf1(Z[r * ZLD + 2048 + (c & 511)]); v = (t < -0.29f) ? 1000.f : 0.f; }
            else if (sel == 23) { const float t = bf1(Z[r * ZLD + 3584 + (c & 511)]); v = (t > 1.001f) ? 1000.f : 0.f; }
            else if (sel == 24) { const float t = bf1(Z[r * ZLD + 3584 + (c & 511)]); v = (t < -0.001f) ? 1000.f : 0.f; }
            else if (sel == 25) { const float t = bf1(Z[r * ZLD + 3584 + (c & 511)]); v = (c < 512 && (t > 1.001f || t < -0.001f)) ? 1000.f * (float)(1 + ((r >> 8) & 127)) : 0.f; }
            else if (sel == 10) v = bf1(((const bf16*)(ws + WS_WOUT0))[i % (1024 * 1024)]);
            args.out[i] = v; }
    }
#endif
#undef RUN
#undef GRID_BAR
}

extern "C" void kernel_launch(void* const* d_in, const int* in_sizes, int n_in, void* d_out, int out_size, void* d_ws, size_t ws_size, hipStream_t stream) {
    static int grid = 0;
    if (grid == 0) {
        if (n_in != 22 || out_size != M_LAT * DM || ws_size < WS_END) { fprintf(stderr, "kernel_launch: unexpected shapes (n_in %d, out %d, ws %zu)\n", n_in, out_size, ws_size); grid = -1; return; }
        int dev = 0, cus = 0, per_cu = 0;
        if (hipGetDevice(&dev) != hipSuccess || hipDeviceGetAttribute(&cus, hipDeviceAttributeMultiprocessorCount, dev) != hipSuccess) { grid = -1; return; }
        if (hipFuncSetAttribute((const void*)hyb_fwd, hipFuncAttributeMaxDynamicSharedMemorySize, LDS_BYTES) != hipSuccess) { fprintf(stderr, "kernel_launch: hipFuncSetAttribute failed\n"); grid = -1; return; }
        if (hipOccupancyMaxActiveBlocksPerMultiprocessor(&per_cu, (const void*)hyb_fwd, NTHREADS, LDS_BYTES) != hipSuccess || per_cu < 1) fprintf(stderr, "kernel_launch: occupancy query reports %d\n", per_cu);
        (void)hipGetLastError();
        grid = cus;
        if (grid != 256) fprintf(stderr, "kernel_launch: %d CUs (built for 256)\n", grid);
    }
    if (grid < 0) return;
    (void)hipMemsetAsync((char*)d_ws + WS_CTL, 0, CTL_ZERO_BYTES, stream);
    Args a{};
    for (int i = 0; i < 22; ++i) a.in[i] = (const float*)d_in[i];
    a.out = (float*)d_out; a.ws = (unsigned char*)d_ws; a.single = 0; a.expert = 0;
#ifndef MAX_LAUNCHES
#define MAX_LAUNCHES 1000
#endif
    int nl = 0;
    auto launch = [&](int code, int layer, int expert) { if (nl++ >= MAX_LAUNCHES) return; a.code = code; a.layer = layer; a.expert = expert; hipLaunchKernelGGL(hyb_fwd, dim3(grid), dim3(NTHREADS), LDS_BYTES, stream, a); };
#ifdef DBG_DUMP
    { const int seq[] = {PH_P0, PH_P1, PH_INPROJ, PH_SCAN_A, PH_OUTPROJ};
      for (int i = 0; i < DBG_NPH; ++i) launch(seq[i], 0, 0);
      launch(99, 0, DBG_DUMP); return; }
#endif
    launch(PH_P0, 0, 0); launch(PH_P1, 0, 0);
    launch(PH_INPROJ, 0, 0); launch(PH_SCAN_A, 0, 0); launch(PH_OUTPROJ, 0, 0); launch(PH_RESLN1, 0, 0); launch(PH_FFNUP, 0, 0); launch(PH_FFNDN, 0, 0); launch(PH_RESLN2, 0, 0);
    launch(PH_INPROJ, 1, 0); launch(PH_SCAN_A, 1, 0); launch(PH_OUTPROJ, 1, 0); launch(PH_RESLN1, 1, 0);
    for (int e = 0; e < NEXP; ++e) { launch(PH_MOEUP, 1, e); launch(PH_MOEDN, 1, e); launch(PH_MOEACC, 1, e); }
    launch(PH_FINAL, 1, 0);
}
```

```cpp
#include <hip/hip_runtime.h>
#include <cstdio>
#include <cstdint>

constexpr int DM = 1024, NBATCH = 8, SEQ = 4096, CTXL = 256, DEPTH = 2;
constexpr int M_LAT = NBATCH * SEQ;
constexpr int M_CTX = NBATCH * CTXL;
constexpr int M_ALL = M_LAT + M_CTX;
constexpr int PROJ = 4112;
constexpr int ZLD = 4096;
constexpr int ZC_HQ = 0, ZC_HF0 = 512, ZC_HF1 = 1024, ZC_HI = 1536, ZC_HG = 2048, ZC_MQ = 2560, ZC_MK = 2816, ZC_MV = 3072, ZC_MO = 3584;
constexpr int DFF = 2816, NEXP = 8, DEXP = 1408;
constexpr float LN_EPS = 1e-5f, RMS_EPS = 1e-6f;
constexpr float DN_ALPHA = 1.41421356237309515f;
constexpr int NWAVES = 8, NTHREADS = 512;

#ifndef IP_K0
#define IP_K0 7
#endif
#ifndef IP_K1
#define IP_K1 6
#endif
#define IP_K(l_) ((l_) ? IP_K1 : IP_K0)
namespace pg8 {
#define PG8_LAS __attribute__((address_space(3)))
typedef unsigned short bf16_t;
typedef short bf16x8 __attribute__((ext_vector_type(8)));
typedef float f32x4 __attribute__((ext_vector_type(4)));
typedef unsigned u32x4 __attribute__((ext_vector_type(4)));
constexpr int BM = 256, BK = 64, HALF = 128, HTB = HALF * BK * 2  , STAGE_BYTES = 8 * HTB, NXCD = 8, WGM = 8;

__host__ __device__ __forceinline__ int lds_byte(int r, int c) { const int st = (r >> 4) * 2 + (c >> 5), rr = r & 15, cc = c & 31, ob = rr * 64 + cc * 2; return st * 1024 + (ob ^ (((ob >> 9) & 1) << 5)); }
__host__ __device__ __forceinline__ void stage_rc(int b, int& R, int& C) { const int st = b / 1024, sb = b % 1024, swz = sb ^ (((sb >> 9) & 1) << 5); R = (st >> 1) * 16 + swz / 64; C = (st & 1) * 32 + (swz % 64) / 2; }
__host__ __device__ __forceinline__ int perm32(int rho) { const int n = rho >> 4, i = rho & 15; return 8 * (i >> 2) + 4 * n + (i & 3); }

struct Unit { int pm, pn; };
struct Gemm { const bf16_t* A; const bf16_t* Bt; int M, N, K; int ld; };

struct StaticOrder {
    int nM, nN, nwg, G, c;
    __host__ __device__ void init(int M, int N, int G_, int c_) { nM = M / BM; nN = N / BM; nwg = nM * nN; G = G_; c = c_; }
    __host__ __device__ bool next(int i, Unit& u) const {
        const long L = (long)i * G + c; if (L >= nwg) return false;
        int wgid = (int)L; { const int q = nwg / NXCD, r = nwg % NXCD, xcd = wgid % NXCD, off = wgid / NXCD; wgid = (xcd < r ? xcd * (q + 1) : r * (q + 1) + (xcd - r) * q) + off; }
        const int nig = WGM * nN, gid = wgid / nig, fm = gid * WGM, gsz = (nM - fm) < WGM ? (nM - fm) : WGM;
        u.pm = fm + ((wgid % nig) % gsz); u.pn = (wgid % nig) / gsz; return true;
    }
    __device__ __forceinline__ void a_ready(const Unit&) const {}
    __device__ __forceinline__ void done(const Unit&) const {}
};
typedef __bf16 bf16x2_nat __attribute__((ext_vector_type(2)));
typedef float f32x2_nat __attribute__((ext_vector_type(2)));
__device__ __forceinline__ unsigned cvt_pk_bf16(float lo, float hi) { const f32x2_nat v = {lo, hi}; const bf16x2_nat r = __builtin_convertvector(v, bf16x2_nat); return __builtin_bit_cast(unsigned, r); }
__device__ __forceinline__ float fsigmoid(float x) { return __builtin_amdgcn_rcpf(1.0f + __expf(-x)); }
__device__ __forceinline__ float fsilu(float x) { return x * fsigmoid(x); }
__device__ __forceinline__ f32x4 silu4(f32x4 v) { return (f32x4){fsilu(v[0]), fsilu(v[1]), fsilu(v[2]), fsilu(v[3])}; }
__device__ __forceinline__ f32x4 sigm4(f32x4 v) { return (f32x4){fsigmoid(v[0]), fsigmoid(v[1]), fsigmoid(v[2]), fsigmoid(v[3])}; }
__device__ __forceinline__ float flogf1(float z, float lb) { z = fminf(fmaxf(z, -30.f), 30.f); const float s = fsigmoid(z); return __log2f(lb + (1.0f - lb) * s); }
__device__ __forceinline__ f32x4 logf4(f32x4 v, f32x4 lb) { return (f32x4){flogf1(v[0], lb[0]), flogf1(v[1], lb[1]), flogf1(v[2], lb[2]), flogf1(v[3], lb[3])}; }
__device__ __forceinline__ u32x4 pack8(f32x4 v0, f32x4 v1) { u32x4 w; w.x = cvt_pk_bf16(v0[0], v0[1]); w.y = cvt_pk_bf16(v0[2], v0[3]); w.z = cvt_pk_bf16(v1[0], v1[1]); w.w = cvt_pk_bf16(v1[2], v1[3]); return w; }

struct EpiZ {
    static constexpr bool PERM = true, AFTER_DRAIN = false;
    bf16_t* O; const float* lbv;
    __device__ __forceinline__ void operator()(const f32x4 (&acc)[2][2][4][2], const Unit& u, int wr, int wc, int fr, int fq) const {
        const int row0 = u.pm * BM + wr * 64 + fr, col0 = u.pn * BM + wc * 32 + 8 * fq;
        const int grp = u.pn >> 1;
#ifdef PROBE_EPIZ_PLAIN
        const int mode = 0; (void)grp;
#else
        const int mode = (grp == 0 || grp == 4) ? 1 : ((grp == 1 || grp == 2) ? 2 : (grp == 7 ? 3 : 0));
#endif
        if (mode == 2) {
            f32x4 lb[2][2];
#pragma unroll
            for (int bj = 0; bj < 2; ++bj)
#pragma unroll
                for (int n = 0; n < 2; ++n) lb[bj][n] = *(const f32x4*)(lbv + (col0 - 512) + bj * HALF + 4 * n);
#pragma unroll
            for (int ai = 0; ai < 2; ++ai)
#pragma unroll
                for (int m = 0; m < 4; ++m) { bf16_t* rowp = O + (size_t)(row0 + ai * HALF + m * 16) * 4096 + col0;
#pragma unroll
                    for (int bj = 0; bj < 2; ++bj) *(u32x4*)(rowp + bj * HALF) = pack8(logf4(acc[ai][bj][m][0], lb[bj][0]), logf4(acc[ai][bj][m][1], lb[bj][1])); }
        } else if (mode == 1) {
#pragma unroll
            for (int ai = 0; ai < 2; ++ai)
#pragma unroll
                for (int m = 0; m < 4; ++m) { bf16_t* rowp = O + (size_t)(row0 + ai * HALF + m * 16) * 4096 + col0;
#pragma unroll
                    for (int bj = 0; bj < 2; ++bj) *(u32x4*)(rowp + bj * HALF) = pack8(silu4(acc[ai][bj][m][0]), silu4(acc[ai][bj][m][1])); }
        } else if (mode == 3) {
#pragma unroll
            for (int ai = 0; ai < 2; ++ai)
#pragma unroll
                for (int m = 0; m < 4; ++m) { bf16_t* rowp = O + (size_t)(row0 + ai * HALF + m * 16) * 4096 + col0;
#pragma unroll
                    for (int bj = 0; bj < 2; ++bj) *(u32x4*)(rowp + bj * HALF) = pack8(sigm4(acc[ai][bj][m][0]), sigm4(acc[ai][bj][m][1])); }
        } else {
#pragma unroll
            for (int ai = 0; ai < 2; ++ai)
#pragma unroll
                for (int m = 0; m < 4; ++m) { bf16_t* rowp = O + (size_t)(row0 + ai * HALF + m * 16) * 4096 + col0;
#pragma unroll
                    for (int bj = 0; bj < 2; ++bj) *(u32x4*)(rowp + bj * HALF) = pack8(acc[ai][bj][m][0], acc[ai][bj][m][1]); }
        }
    }
};
struct EpiPlain {
    static constexpr bool PERM = true, AFTER_DRAIN = false;
    bf16_t* O; int ldc; int pn_mod;
    __device__ __forceinline__ void operator()(const f32x4 (&acc)[2][2][4][2], const Unit& u, int wr, int wc, int fr, int fq) const {
        const int row0 = u.pm * BM + wr * 64 + fr, col0 = (u.pn % pn_mod) * BM + wc * 32 + 8 * fq;
#pragma unroll
        for (int ai = 0; ai < 2; ++ai)
#pragma unroll
            for (int m = 0; m < 4; ++m) { bf16_t* rowp = O + (size_t)(row0 + ai * HALF + m * 16) * ldc + col0;
#pragma unroll
                for (int bj = 0; bj < 2; ++bj) *(u32x4*)(rowp + bj * HALF) = pack8(acc[ai][bj][m][0], acc[ai][bj][m][1]); }
    }
};
struct EpiSwiGLU {
    static constexpr bool PERM = true, AFTER_DRAIN = false;
    bf16_t* H; int ldh; int pn_mod; int blk;
    __device__ __forceinline__ void operator()(const f32x4 (&acc)[2][2][4][2], const Unit& u, int wr, int wc, int fr, int fq) const {
        const int col0 = (u.pn % pn_mod) * HALF + wc * 32 + 8 * fq;
        const int rs = blk ? BK : ldh;
        bf16_t* base = blk ? H + ((size_t)(u.pm * (ldh / BK) + (col0 >> 6)) * BM + wr * 64 + fr) * BK + (col0 & 63) : H + (size_t)(u.pm * BM + wr * 64 + fr) * ldh + col0;
#pragma unroll
        for (int ai = 0; ai < 2; ++ai)
#pragma unroll
            for (int m = 0; m < 4; ++m) { bf16_t* rowp = base + (size_t)(ai * HALF + m * 16) * rs;
                *(u32x4*)rowp = pack8(silu4(acc[ai][0][m][0]) * acc[ai][1][m][0], silu4(acc[ai][0][m][1]) * acc[ai][1][m][1]); }
    }
};

struct MoeOrder {
    int npn, nwg, G, c; int ps[7];
    __device__ __forceinline__ void init(const int* meta, int npn_, int G_, int c_) { npn = npn_; G = G_; c = c_;
#pragma unroll
        for (int k = 0; k < 7; ++k) ps[k] = __builtin_amdgcn_readfirstlane(meta[k + 1]);
        nwg = __builtin_amdgcn_readfirstlane(meta[8]) * npn_; }
    __device__ __forceinline__ bool next(int i, Unit& u) const {
        const long L = (long)i * G + c; if (L >= nwg) return false;
        int wgid = (int)L; { const int q = nwg / NXCD, r = nwg % NXCD, xcd = wgid % NXCD, off = wgid / NXCD; wgid = (xcd < r ? xcd * (q + 1) : r * (q + 1) + (xcd - r) * q) + off; }
        const int pm = wgid / npn, pl = wgid - pm * npn; int ex = 0;
#pragma unroll
        for (int k = 0; k < 7; ++k) ex += (pm >= ps[k]) ? 1 : 0;
        u.pm = pm; u.pn = ex * npn + pl; return true;
    }
    __device__ __forceinline__ void a_ready(const Unit&) const {}
    __device__ __forceinline__ void done(const Unit&) const {}
};

__device__ __forceinline__ void moe_release(int nd, int fr, unsigned* rfull, unsigned* rtail, int wv) {
    if (nd == fr || nd == fr + 1) {
        asm volatile("s_waitcnt vmcnt(0)" ::: "memory"); __builtin_amdgcn_s_barrier(); asm volatile("" ::: "memory");
        if (wv == 0 && __lane_id() == 0) { __builtin_amdgcn_fence(__ATOMIC_RELEASE, "agent"); asm volatile("s_waitcnt vmcnt(0)" ::: "memory");
            __hip_atomic_fetch_add(nd == fr ? rfull : rtail, 1u, __ATOMIC_RELAXED, __HIP_MEMORY_SCOPE_AGENT); } }
}
struct MoeUpOrder : MoeOrder {
    unsigned* rfull; unsigned* rtail; int wv; mutable int nd;
    __device__ __forceinline__ void done(const Unit&) const { ++nd; moe_release(nd, nwg / G, rfull, rtail, wv); }
};
struct MoeDnOrder : MoeOrder {
    const unsigned* rtail; unsigned ntail; int nwg_up, wv; mutable int na, got;
    unsigned* dfull; unsigned* dtail; mutable int nd;
    __device__ __forceinline__ void done(const Unit&) const { ++nd; moe_release(nd, nwg / G, dfull, dtail, wv); }
    __device__ __forceinline__ bool tail_panel(int pm) const {
        const int a = 11 * pm, b = a + 11, q = nwg_up / NXCD, r = nwg_up % NXCD, thr = (nwg_up / G) * (G / NXCD); int st = 0; bool any = false;
#pragma unroll
        for (int x = 0; x < NXCD; ++x) { const int sz = q + (x < r ? 1 : 0), lo = st + thr, hi = st + sz; any = any || ((a > lo ? a : lo) < (b < hi ? b : hi)); st += sz; }
        return any;
    }
    __device__ __forceinline__ void a_ready(const Unit& u) const {
        const int i = na; ++na;
        if (got || (i == 0 && !tail_panel(u.pm))) return;
        if (wv == 0) { unsigned sp = 0;
            while ((unsigned)__builtin_amdgcn_readfirstlane(__hip_atomic_load(rtail, __ATOMIC_RELAXED, __HIP_MEMORY_SCOPE_AGENT)) < ntail) { __builtin_amdgcn_s_sleep(1); if (++sp > (1u << 22)) break; }
            __builtin_amdgcn_fence(__ATOMIC_ACQUIRE, "agent"); asm volatile("s_waitcnt vmcnt(0)" ::: "memory"); }
        asm volatile("" ::: "memory"); __builtin_amdgcn_s_barrier(); asm volatile("" ::: "memory");
        got = 1;
    }
};

struct SubsetOrder : StaticOrder {
    int k, inner;
    __device__ __forceinline__ bool next(int i, Unit& u) const {
        if (!StaticOrder::next(i, u)) return false;
        const int p = u.pm;
        if (inner) { const int per = 16 - 2 * k; u.pm = 16 * (p / per) + k + p % per; }
        else { const int per = 2 * k; if (p >= 8 * per) u.pm = 128 + (p - 8 * per); else { const int j = p % per; u.pm = 16 * (p / per) + (j < k ? j : j + 16 - per); } }
        u.pn = 2 * ((0x65734201u >> (4 * (u.pn >> 1))) & 7u) + (u.pn & 1);
        return true;
    }
};
template <class Epi, class Sched, bool ALIGN_EPI = false, bool SP2 = false, bool GATHER = false, bool ABLK = false>
__device__ __forceinline__ void gemm_phase(PG8_LAS unsigned char* lds, const Gemm g, const Sched& S, const Epi& E, int tid_in, const int* gtab = nullptr) {
    int tid_ = tid_in; asm volatile("" : "+v"(tid_));
    const int tid = tid_, wid = __builtin_amdgcn_readfirstlane(tid >> 6), lane = tid & 63, wr = wid >> 2, wc = wid & 3, fr = lane & 15, fq = lane >> 4;
    const int K = g.K, nt = K / BK, LD = g.ld ? g.ld : g.K, LDA = ABLK ? BK : LD;
    unsigned voffA[2], voffB[2]; int rA[2]; unsigned cA2[2];
#pragma unroll
    for (int i = 0; i < 2; ++i) { int R, C; stage_rc(tid * 16 + i * 8192, R, C); const int Rb = Epi::PERM ? ((R & ~31) + perm32(R & 31)) : R;
        voffA[i] = (unsigned)(R * LDA + C) * 2u; voffB[i] = (unsigned)(Rb * LD + C) * 2u; rA[i] = R; cA2[i] = (unsigned)C * 2u; }
    const size_t kstep = (size_t)(BK * 2);
    const size_t hstep = (size_t)HALF * LD * 2;
    const size_t tstep = 2 * hstep;
    const size_t kstepA = ABLK ? (size_t)(256 * BK * 2) : kstep, hstepA = ABLK ? (size_t)(HALF * BK * 2) : hstep, tstepA = ABLK ? (size_t)nt * (256 * BK * 2) : tstep;
    const unsigned ldsw = (unsigned)wid * 1024u;
    const int aoff = lds_byte(wr * 64 + fr, fq * 8), boff = lds_byte(wc * 32 + fr, fq * 8);
#define PG8_SA(b, h) (((b) * 2 + (h)) * HTB)
#define PG8_SB(b, h) ((4 + (b) * 2 + (h)) * HTB)
#define PG8_STAGE(bufoff, gbase, voff) do { _Pragma("unroll") for (int _i = 0; _i < 2; ++_i) \
        __builtin_amdgcn_global_load_lds((const unsigned*)((const char*)(gbase) + (voff)[_i]), (PG8_LAS unsigned*)(lds + (bufoff) + ldsw + _i * 8192), 16, 0, 0); } while (0)
#define PG8_LDA(dst, b, h) do { _Pragma("unroll") for (int m = 0; m < 4; ++m) _Pragma("unroll") for (int k = 0; k < 2; ++k) dst[m][k] = *(const PG8_LAS bf16x8*)(lds + PG8_SA(b, h) + aoff + m * 2048 + k * 1024); } while (0)
#define PG8_LDB(dst, b, h) do { _Pragma("unroll") for (int n = 0; n < 2; ++n) _Pragma("unroll") for (int k = 0; k < 2; ++k) dst[n][k] = *(const PG8_LAS bf16x8*)(lds + PG8_SB(b, h) + boff + n * 2048 + k * 1024); } while (0)
#define PG8_MMA(ai, bj, At, Bt) do { __builtin_amdgcn_s_setprio(1); _Pragma("unroll") for (int m = 0; m < 4; ++m) _Pragma("unroll") for (int n = 0; n < 2; ++n) _Pragma("unroll") for (int k = 0; k < 2; ++k) \
        acc[ai][bj][m][n] = __builtin_amdgcn_mfma_f32_16x16x32_bf16(Bt[n][k], At[m][k], acc[ai][bj][m][n], 0, 0, 0); __builtin_amdgcn_s_setprio(0); } while (0)
#define PG8_WAIT_V(n) asm volatile("s_waitcnt vmcnt(" #n ")" ::: "memory")
#define PG8_WAIT_L(n) asm volatile("s_waitcnt lgkmcnt(" #n ")" ::: "memory")
#define PG8_BAR __builtin_amdgcn_s_barrier()
#define PG8_SCHED __builtin_amdgcn_sched_barrier(0)
    Unit cur, nxt; int ui = 0;
    if (!S.next(0, cur)) return;
    f32x4 acc[2][2][4][2];
#pragma unroll
    for (int a = 0; a < 2; ++a)
#pragma unroll
        for (int b = 0; b < 2; ++b)
#pragma unroll
            for (int m = 0; m < 4; ++m)
#pragma unroll
                for (int n = 0; n < 2; ++n) acc[a][b][m][n] = (f32x4){0.f, 0.f, 0.f, 0.f};
    bf16x8 At[4][2], B0[2][2], B1[2][2];
    const char* cA = GATHER ? (const char*)g.A : (const char*)g.A + (size_t)cur.pm * tstepA; const char* cB = (const char*)g.Bt + (size_t)cur.pn * tstep;
    unsigned cva0[2], cva1[2], nva0[2], nva1[2];
#pragma unroll
    for (int i = 0; i < 2; ++i) {
        if constexpr (GATHER) { cva0[i] = ((unsigned)gtab[cur.pm * 256 + rA[i]] * (unsigned)LD) * 2u + cA2[i]; cva1[i] = ((unsigned)gtab[cur.pm * 256 + 128 + rA[i]] * (unsigned)LD) * 2u + cA2[i]; }
        else { cva0[i] = voffA[i]; cva1[i] = voffA[i] + (unsigned)hstepA; }
        nva0[i] = cva0[i]; nva1[i] = cva1[i]; }
    S.a_ready(cur);
    if constexpr (SP2) {
        PG8_STAGE(PG8_SB(0, 0), cB, voffB); PG8_STAGE(PG8_SB(0, 1), cB + hstep, voffB); PG8_STAGE(PG8_SA(0, 0), cA, cva0); PG8_STAGE(PG8_SA(0, 1), cA, cva1);
        if (wr == 1) PG8_BAR;
        PG8_WAIT_V(2); PG8_BAR;
        PG8_STAGE(PG8_SB(1, 0), cB + kstep, voffB); PG8_STAGE(PG8_SA(1, 0), cA + kstepA, cva0); PG8_STAGE(PG8_SB(1, 1), cB + hstep + kstep, voffB);
        PG8_WAIT_V(6); PG8_BAR;
    } else {
        PG8_STAGE(PG8_SB(0, 0), cB, voffB); PG8_STAGE(PG8_SA(0, 0), cA, cva0); PG8_STAGE(PG8_SB(0, 1), cB + hstep, voffB); PG8_STAGE(PG8_SA(0, 1), cA, cva1);
        if (wr == 1) PG8_BAR;
        PG8_WAIT_V(4); PG8_BAR;
        PG8_STAGE(PG8_SB(1, 0), cB + kstep, voffB); PG8_STAGE(PG8_SA(1, 0), cA + kstepA, cva0); PG8_STAGE(PG8_SB(1, 1), cB + hstep + kstep, voffB);
        PG8_WAIT_V(6); PG8_BAR;
    }
    for (;;) {
        const bool has_next = S.next(ui + 1, nxt);
        const char* nA = (has_next && !GATHER) ? (const char*)g.A + (size_t)nxt.pm * tstepA : cA; const char* nB = has_next ? (const char*)g.Bt + (size_t)nxt.pn * tstep : cB;
        if constexpr (GATHER) { if (has_next) {
#pragma unroll
            for (int i = 0; i < 2; ++i) { nva0[i] = ((unsigned)gtab[nxt.pm * 256 + rA[i]] * (unsigned)LD) * 2u + cA2[i]; nva1[i] = ((unsigned)gtab[nxt.pm * 256 + 128 + rA[i]] * (unsigned)LD) * 2u + cA2[i]; } } }
        for (int t = 0; t < nt; t += 2) {
            const bool last = (t == nt - 2);
            const char* a1 = cA + (size_t)(t + 1) * kstepA;
            const char* a2 = last ? nA : cA + (size_t)(t + 2) * kstepA; const char* b2 = last ? nB : cB + (size_t)(t + 2) * kstep;
            const char* a3 = a2 + kstepA; const char* b3 = b2 + kstep;
            unsigned sva0[2], sva1[2];
#pragma unroll
            for (int i = 0; i < 2; ++i) { sva0[i] = (GATHER && last) ? nva0[i] : cva0[i]; sva1[i] = (GATHER && last) ? nva1[i] : cva1[i]; }
            if (last && has_next) S.a_ready(nxt);
            if constexpr (SP2) {
            PG8_LDB(B0, 0, 0); PG8_LDB(B1, 0, 1); PG8_SCHED; PG8_LDA(At, 0, 0); PG8_STAGE(PG8_SA(1, 1), a1, cva1);
            PG8_WAIT_V(8); PG8_WAIT_L(0); PG8_BAR; PG8_MMA(0, 0, At, B0); PG8_MMA(0, 1, At, B1); PG8_BAR; PG8_SCHED;
            PG8_LDA(At, 0, 1); PG8_STAGE(PG8_SB(0, 0), b2, voffB); PG8_STAGE(PG8_SB(0, 1), b2 + hstep, voffB); PG8_STAGE(PG8_SA(0, 0), a2, sva0);
            PG8_WAIT_V(8); PG8_WAIT_L(0); PG8_BAR; PG8_MMA(1, 0, At, B0); PG8_MMA(1, 1, At, B1); PG8_BAR; PG8_SCHED;
            PG8_LDB(B0, 1, 0); PG8_LDB(B1, 1, 1); PG8_SCHED; PG8_LDA(At, 1, 0); PG8_STAGE(PG8_SA(0, 1), a2, sva1);
            PG8_WAIT_V(8); PG8_WAIT_L(0); PG8_BAR; PG8_MMA(0, 0, At, B0); PG8_MMA(0, 1, At, B1); PG8_BAR; PG8_SCHED;
            PG8_LDA(At, 1, 1); PG8_STAGE(PG8_SB(1, 0), b3, voffB); PG8_STAGE(PG8_SB(1, 1), b3 + hstep, voffB); PG8_STAGE(PG8_SA(1, 0), a3, sva0);
            PG8_WAIT_V(8); PG8_WAIT_L(0); PG8_BAR; PG8_MMA(1, 0, At, B0); PG8_MMA(1, 1, At, B1); PG8_BAR; PG8_SCHED;
            } else {
            PG8_LDB(B0, 0, 0); PG8_SCHED; PG8_LDA(At, 0, 0); PG8_STAGE(PG8_SA(1, 1), a1, cva1);
            PG8_WAIT_L(8); PG8_BAR; PG8_WAIT_L(0); PG8_MMA(0, 0, At, B0); PG8_BAR; PG8_SCHED;
            PG8_LDB(B1, 0, 1); PG8_STAGE(PG8_SB(0, 0), b2, voffB);
            PG8_BAR; PG8_WAIT_L(0); PG8_MMA(0, 1, At, B1); PG8_BAR;
            PG8_LDA(At, 0, 1); PG8_STAGE(PG8_SA(0, 0), a2, sva0);
            PG8_BAR; PG8_WAIT_L(0); PG8_MMA(1, 0, At, B0); PG8_BAR; PG8_SCHED;
            PG8_STAGE(PG8_SB(0, 1), b2 + hstep, voffB);
            PG8_WAIT_V(6); PG8_BAR; PG8_MMA(1, 1, At, B1); PG8_BAR;
            PG8_LDB(B0, 1, 0); PG8_SCHED; PG8_LDA(At, 1, 0); PG8_STAGE(PG8_SA(0, 1), a2, sva1);
            PG8_WAIT_L(8); PG8_BAR; PG8_WAIT_L(0); PG8_MMA(0, 0, At, B0); PG8_BAR; PG8_SCHED;
            PG8_LDB(B1, 1, 1); PG8_STAGE(PG8_SB(1, 0), b3, voffB);
            PG8_BAR; PG8_WAIT_L(0); PG8_MMA(0, 1, At, B1); PG8_BAR;
            PG8_LDA(At, 1, 1); PG8_STAGE(PG8_SA(1, 0), a3, sva0);
            PG8_BAR; PG8_WAIT_L(0); PG8_MMA(1, 0, At, B0); PG8_BAR; PG8_SCHED;
            PG8_STAGE(PG8_SB(1, 1), b3 + hstep, voffB);
            PG8_WAIT_V(6); PG8_BAR; PG8_MMA(1, 1, At, B1); PG8_BAR;
            }
        }
        if constexpr (ALIGN_EPI) { if (wr == 0) PG8_BAR; }
        if constexpr (!Epi::AFTER_DRAIN) { E(acc, cur, wr, wc, fr, fq); S.done(cur); }
        if (!has_next) break;
#pragma unroll
        for (int a = 0; a < 2; ++a)
#pragma unroll
            for (int b = 0; b < 2; ++b)
#pragma unroll
                for (int m = 0; m < 4; ++m)
#pragma unroll
                    for (int n = 0; n < 2; ++n) acc[a][b][m][n] = (f32x4){0.f, 0.f, 0.f, 0.f};
        cur = nxt; cA = nA; cB = nB; ++ui;
#pragma unroll
        for (int i = 0; i < 2; ++i) { cva0[i] = nva0[i]; cva1[i] = nva1[i]; }
        if constexpr (ALIGN_EPI) { if (wr == 1) PG8_BAR; }
    }
    PG8_WAIT_V(0);
    if constexpr (!ALIGN_EPI) { if (wr == 0) PG8_BAR; }
    PG8_BAR;
    if constexpr (Epi::AFTER_DRAIN) { E.fused(acc, cur, wr, wc, fr, fq, lds, wid, lane); S.done(cur); }
#undef PG8_SA
#undef PG8_SB
#undef PG8_STAGE
#undef PG8_LDA
#undef PG8_LDB
#undef PG8_MMA
#undef PG8_WAIT_V
#undef PG8_WAIT_L
#undef PG8_BAR
#undef PG8_SCHED
}
}
constexpr size_t MiB = 1u << 20;
constexpr size_t WS_CTL = 0, CTL_ZERO_BYTES = 1 * MiB;
constexpr size_t WS_MODF = 1 * MiB;
constexpr size_t WS_LBV = 1 * MiB + 512 * 1024;
constexpr size_t WS_GATES = 2 * MiB;
constexpr size_t WS_TOPE = 5 * MiB;
constexpr size_t WS_TOPP = 5 * MiB + 256 * 1024;
constexpr size_t WS_WHIST = 6 * MiB;
constexpr size_t WS_META = 6 * MiB + 64 * 1024;
constexpr size_t WS_SLOTTOK = 6 * MiB + 128 * 1024;
constexpr size_t WS_TOKSLOT = 7 * MiB;
constexpr size_t WS_STATE = 8 * MiB;
constexpr size_t WS_XC = 24 * MiB;
constexpr size_t WS_CFB = 32 * MiB;
constexpr size_t WS_WIN0 = 40 * MiB, WS_WOUT0 = 48 * MiB, WS_FGU = 50 * MiB, WS_FDN = 61 * MiB, WS_WG = 66 * MiB + 512 * 1024;
constexpr size_t WS_WIN1 = 68 * MiB, WS_WOUT1 = 76 * MiB, WS_MGU = 78 * MiB, WS_MDN = 122 * MiB;
constexpr size_t WS_Z = 146 * MiB;
constexpr size_t WS_A1 = 418 * MiB;
constexpr size_t WS_FC = 486 * MiB, WS_HC = 490 * MiB, WS_F2C = 502 * MiB;
constexpr size_t WS_END = 506 * MiB;
constexpr size_t ZOFF_F2 = 192 * MiB, ZOFF_OPERM = 182 * MiB;
constexpr int CW_BAR = 4096;
constexpr int CW_CC = 8192, CW_SUB = 8256, CW_IP2 = 8320  , CW_MFULL = 8448, CW_MTAIL = 8512  , CW_DFULL = 8576, CW_DTAIL = 8640  , CW_BAR2 = 12288;

constexpr int RING_BYTES = 131072;
constexpr int LDSCTL_OFF = 163840 - 4096, MISC_OFF = LDSCTL_OFF + 320;
constexpr int LDS_BYTES = 163840;

#define GAS __attribute__((address_space(1)))
#define LAS __attribute__((address_space(3)))
typedef unsigned short bf16;
typedef unsigned v4u __attribute__((ext_vector_type(4)));
typedef unsigned v2u __attribute__((ext_vector_type(2)));
typedef float f32x4 __attribute__((ext_vector_type(4)));
typedef float f32x2 __attribute__((ext_vector_type(2)));
typedef GAS unsigned gu32;
#define LDS_WAIT() asm volatile("s_waitcnt lgkmcnt(0)" ::: "memory")
#define VM_WAIT() asm volatile("s_waitcnt vmcnt(0)" ::: "memory")
__device__ __forceinline__ unsigned f2bf(float f) { unsigned u = __builtin_bit_cast(unsigned, f); return (u + 0x7fffu + ((u >> 16) & 1u)) >> 16; }
__device__ __forceinline__ unsigned pk2(float lo, float hi) { return pg8::cvt_pk_bf16(lo, hi); }
__device__ __forceinline__ float bf_lo(unsigned w) { return __builtin_bit_cast(float, w << 16); }
__device__ __forceinline__ float bf_hi(unsigned w) { return __builtin_bit_cast(float, w & 0xffff0000u); }
typedef _Float16 h16x2 __attribute__((ext_vector_type(2)));
__device__ __forceinline__ unsigned pkh(float lo, float hi) { return __builtin_bit_cast(unsigned, __builtin_convertvector((f32x2){lo, hi}, h16x2)); }
__device__ __forceinline__ f32x2 unh(unsigned w) { return __builtin_convertvector(__builtin_bit_cast(h16x2, w), f32x2); }
__device__ __forceinline__ float bf1(bf16 b) { return __builtin_bit_cast(float, ((unsigned)b) << 16); }
__device__ __forceinline__ float sigmoidf_(float x) { return 1.0f / (1.0f + __expf(-x)); }
#define DPP_F(old_, src_, ctrl_, rm_) __builtin_bit_cast(float, __builtin_amdgcn_update_dpp(__builtin_bit_cast(int, (old_)), __builtin_bit_cast(int, (src_)), (ctrl_), (rm_), 0xf, false))
__device__ __forceinline__ float wave_scan_add(float x) {
    x += DPP_F(0.f, x, 0x111, 0xf); x += DPP_F(0.f, x, 0x112, 0xf); x += DPP_F(0.f, x, 0x114, 0xf); x += DPP_F(0.f, x, 0x118, 0xf);
    x += DPP_F(0.f, x, 0x142, 0xa); x += DPP_F(0.f, x, 0x143, 0xc); return x;
}
__device__ __forceinline__ float wave_scan_max(float x) {
    const float ninf = -3.0e38f;
    x = fmaxf(x, DPP_F(ninf, x, 0x111, 0xf)); x = fmaxf(x, DPP_F(ninf, x, 0x112, 0xf)); x = fmaxf(x, DPP_F(ninf, x, 0x114, 0xf)); x = fmaxf(x, DPP_F(ninf, x, 0x118, 0xf));
    x = fmaxf(x, DPP_F(ninf, x, 0x142, 0xa)); x = fmaxf(x, DPP_F(ninf, x, 0x143, 0xc)); return x;
}
__device__ __forceinline__ int wave_sum_i(int x) {
#define DPP_I(src_, ctrl_, rm_) __builtin_amdgcn_update_dpp(0, (src_), (ctrl_), (rm_), 0xf, false)
    x += DPP_I(x, 0x111, 0xf); x += DPP_I(x, 0x112, 0xf); x += DPP_I(x, 0x114, 0xf); x += DPP_I(x, 0x118, 0xf); x += DPP_I(x, 0x142, 0xa); x += DPP_I(x, 0x143, 0xc);
#undef DPP_I
    return __builtin_amdgcn_readlane(x, 63);
}
__device__ __forceinline__ float wave_sum(float v) { return __builtin_bit_cast(float, __builtin_amdgcn_readlane(__builtin_bit_cast(int, wave_scan_add(v)), 63)); }
#define XB_TMO      128
#define XB_XCNT(j)  (256  + 64 * (j))
#define XB_XSUB(j)  (1280 + 64 * (j))
#define XB_XGEN(j)  (2304 + 64 * (j))
#define XB_TOP      3328
#define XB_TOPGEN   3392
#define XCD_BAR_WORDS 3456
#define XB_SPIN_CAP (1u << 18)

__device__ __forceinline__ unsigned xb_ld(unsigned* p)              { return __hip_atomic_load(p, __ATOMIC_RELAXED, __HIP_MEMORY_SCOPE_AGENT); }
__device__ __forceinline__ unsigned xb_add(unsigned* p, unsigned v) { return __hip_atomic_fetch_add(p, v, __ATOMIC_RELAXED, __HIP_MEMORY_SCOPE_AGENT); }
__device__ __forceinline__ unsigned xb_xcc_id() { return (unsigned)__builtin_amdgcn_s_getreg((3 << 11) | 20) & 0xFu; }
#define XB_SPIN(cond, bar) do { unsigned _sp = 0; while (cond) { __builtin_amdgcn_s_sleep(1); \
    if ((++_sp & 255u) == 0u) { if (xb_ld(&(bar)[XB_TMO])) break; if (_sp > XB_SPIN_CAP) { atomicAdd(&(bar)[XB_TMO], 1u); break; } } } } while (0)

struct XcdBarrier {
    unsigned* bar; unsigned x;
    unsigned members;
    volatile LAS unsigned* st;
};

__device__ __forceinline__ XcdBarrier xcd_barrier_post(unsigned* bar, volatile LAS unsigned* st, bool leader) {
    XcdBarrier b; b.bar = bar; b.x = xb_xcc_id(); b.st = st; b.members = 0u;
    if (leader) (void)xb_add(&bar[XB_XCNT(b.x)], 1u);
    return b;
}
__device__ __forceinline__ void xcd_barrier_complete(unsigned* bar, unsigned x, unsigned& nloc, unsigned& nx, unsigned members) {
    const unsigned G = members ? members : gridDim.x * gridDim.y * gridDim.z;
    unsigned sum, cnt, mine, sp = 0u;
    for (;;) {
        sum = 0u; cnt = 0u; mine = 0u;
#pragma unroll
        for (unsigned j = 0; j < 16; ++j) { const unsigned c = xb_ld(&bar[XB_XCNT(j)]); sum += c; cnt += (c > 0u) ? 1u : 0u; mine = (j == x) ? c : mine; }
        if (sum == G) break;
        __builtin_amdgcn_s_sleep(1);
        if ((++sp & 255u) == 0u) { if (xb_ld(&bar[XB_TMO])) break; if (sp > XB_SPIN_CAP) { atomicAdd(&bar[XB_TMO], 1u); break; } }
    }
    nloc = mine > 0u ? mine : 1u; nx = cnt > 0u ? cnt : 1u;
}

__device__ __forceinline__ void xcd_barrier(const XcdBarrier& b, bool leader) {
    asm volatile("s_waitcnt vmcnt(0)" ::: "memory");
    __syncthreads();
    if (leader) {
        unsigned* bar = b.bar; unsigned bx = b.x; asm volatile("" : "+v"(bx));
        __builtin_amdgcn_s_waitcnt(0);
        unsigned nloc = b.st[0], nx = b.st[1];
        if (nloc == 0u) { xcd_barrier_complete(bar, bx, nloc, nx, b.members); b.st[0] = nloc; b.st[1] = nx; }
        const unsigned old = xb_add(&bar[XB_XSUB(bx)], 1u);
        const unsigned gen = old / nloc;
        if (old + 1u == (gen + 1u) * nloc) {
            __builtin_amdgcn_fence(__ATOMIC_RELEASE, "agent");
            asm volatile("s_waitcnt vmcnt(0)" ::: "memory");
            const unsigned og = xb_add(&bar[XB_TOP], 1u);
            const unsigned tg = og / nx;
            if (og + 1u == (tg + 1u) * nx) xb_add(&bar[XB_TOPGEN], 1u);
            else XB_SPIN(xb_ld(&bar[XB_TOPGEN]) == tg, bar);
            __builtin_amdgcn_fence(__ATOMIC_ACQUIRE, "agent");
            xb_add(&bar[XB_XGEN(bx)], 1u);
            asm volatile("s_waitcnt vmcnt(0)" ::: "memory");
        } else {
            XB_SPIN(xb_ld(&bar[XB_XGEN(bx)]) == gen, bar);
            __builtin_amdgcn_fence(__ATOMIC_ACQUIRE, "agent");
            asm volatile("s_waitcnt vmcnt(0)" ::: "memory");
        }
    }
    __syncthreads();
}
struct Args { const float* in[22]; float* out; unsigned char* ws; int code, layer, expert, single; };
enum { IN_X = 0, IN_C, IN_CTX, IN_CCTX, IN_WADA, IN_BADA, IN_WIN, IN_CONVW, IN_CONVB, IN_HLB, IN_GBIAS, IN_HGNORM, IN_MLNORM, IN_WOUT, IN_LNG, IN_LNB,
       IN_FGU, IN_FDN, IN_RW, IN_RB, IN_MGU, IN_MDN };
enum { PH_P0 = 0, PH_P1, PH_INPROJ, PH_SCAN_A, PH_SCAN_B, PH_OUTPROJ, PH_RESLN1, PH_FFNUP, PH_FFNDN, PH_RESLN2, PH_MOEUP, PH_MOEDN, PH_MOEACC, PH_FINAL };
constexpr int PTAB_OFF = LDSCTL_OFF + 1024;
struct Frame {
    LAS unsigned char* lds;
    int tid, lane, wave, bid, G;
    unsigned char* ws;
    __device__ __forceinline__ const float* in(int i) const { const unsigned long long v = ((const LAS unsigned long long*)(lds + PTAB_OFF))[i];
        const unsigned lo = __builtin_amdgcn_readfirstlane((unsigned)v), hi = __builtin_amdgcn_readfirstlane((unsigned)(v >> 32)); return (const float*)(((unsigned long long)hi << 32) | lo); }
};
__device__ __forceinline__ Frame phase_frame(const Frame& F0) {
    Frame F = F0; int lid; asm volatile("v_mbcnt_lo_u32_b32 %0, -1, 0\n\tv_mbcnt_hi_u32_b32 %0, -1, %0" : "=v"(lid));
    int t = F0.wave * 64 + lid, b = F0.bid; unsigned long long w = (unsigned long long)F0.ws; unsigned lb = (unsigned)(unsigned long long)F0.lds;
    asm volatile("" : "+v"(t)); asm volatile("" : "+s"(b)); asm volatile("" : "+s"(w)); asm volatile("" : "+s"(lb));
    F.tid = t; F.lane = t & 63; F.wave = __builtin_amdgcn_readfirstlane(t >> 6); F.bid = b; F.ws = (unsigned char*)w; F.lds = (LAS unsigned char*)lb; return F;
}

__device__ __forceinline__ void transpose_item(const float* W, int ldn, int k0, int src_col0, bf16* WT, int ldk, int dst_row0, LAS float* scr, int lane) {
    float tv[32];
    const float* wp = W + (size_t)(k0 + (lane >> 5)) * ldn + src_col0 + (lane & 31);
#pragma unroll
    for (int i = 0; i < 32; ++i) tv[i] = wp[(size_t)(2 * i) * ldn];
#pragma unroll
    for (int i = 0; i < 32; ++i) scr[(2 * i + (lane >> 5)) * 33 + (lane & 31)] = tv[i];
    LDS_WAIT(); asm volatile("" ::: "memory");
    const int c = lane & 7;
#pragma unroll
    for (int j = 0; j < 4; ++j) { const int n = (lane >> 3) + 8 * j; const LAS float* s = scr + (8 * c) * 33 + n;
        v4u o; o.x = pk2(s[0 * 33], s[1 * 33]); o.y = pk2(s[2 * 33], s[3 * 33]); o.z = pk2(s[4 * 33], s[5 * 33]); o.w = pk2(s[6 * 33], s[7 * 33]);
        *(GAS v4u*)(WT + (size_t)(dst_row0 + n) * ldk + k0 + 8 * c) = o; }
    LDS_WAIT(); asm volatile("" ::: "memory");
}
constexpr int T_WIN = 16 * 128, T_WOUT = 16 * 32, T_FGU = 16 * 176, T_FDN = 44 * 32, T_MGU = 8 * 16 * 88, T_MDN = 8 * 22 * 32;
constexpr int T_TOTAL = 2 * T_WIN + 2 * T_WOUT + T_FGU + T_FDN + T_MGU + T_MDN;
__device__ __forceinline__ void weight_item(const Frame& F, int r, LAS float* scr) {
    unsigned char* ws = F.ws;
#pragma unroll 1
    for (int l = 0; l < 2; ++l) {
        if (r < T_WIN) { const int nb = r % 128, kb = r / 128;
            transpose_item(F.in(IN_WIN) + (size_t)l * 1024 * PROJ, PROJ, 64 * kb, 32 * nb + (nb >= 112 ? 16 : 0), (bf16*)(ws + (l ? WS_WIN1 : WS_WIN0)), 1024, 32 * nb, scr, F.lane); return; }
        r -= T_WIN;
        if (r < T_WOUT) { const int nb = r % 32, kb = r / 32;
            transpose_item(F.in(IN_WOUT) + (size_t)l * 1024 * 1024, 1024, 64 * kb, 32 * nb, (bf16*)(ws + (l ? WS_WOUT1 : WS_WOUT0)), 1024, 32 * nb, scr, F.lane); return; }
        r -= T_WOUT;
        if (l == 0) {
            if (r < T_FGU) { const int nb = r % 176, kb = r / 176, pn = nb >> 3, bj = (nb >> 2) & 1, jb = nb & 3;
                transpose_item(F.in(IN_FGU), 2 * DFF, 64 * kb, bj * DFF + 128 * pn + 32 * jb, (bf16*)(ws + WS_FGU), 1024, 32 * nb, scr, F.lane); return; }
            r -= T_FGU;
            if (r < T_FDN) { const int nb = r % 32, kb = r / 32;
                transpose_item(F.in(IN_FDN), 1024, 64 * kb, 32 * nb, (bf16*)(ws + WS_FDN), DFF, 32 * nb, scr, F.lane); return; }
            r -= T_FDN;
        } else {
            if (r < T_MGU) { const int e = r / 1408, rr = r % 1408, nb = rr % 88, kb = rr / 88, pn = nb >> 3, bj = (nb >> 2) & 1, jb = nb & 3;
                transpose_item(F.in(IN_MGU) + (size_t)e * 1024 * 2 * DEXP, 2 * DEXP, 64 * kb, bj * DEXP + 128 * pn + 32 * jb, (bf16*)(ws + WS_MGU) + (size_t)e * 2 * DEXP * 1024, 1024, 32 * nb, scr, F.lane); return; }
            r -= T_MGU;
            if (r < T_MDN) { const int e = r / 704, rr = r % 704, nb = rr % 32, kb = rr / 32;
                transpose_item(F.in(IN_MDN) + (size_t)e * DEXP * 1024, 1024, 64 * kb, 32 * nb, (bf16*)(ws + WS_MDN) + (size_t)e * 1024 * DEXP, DEXP, 32 * nb, scr, F.lane); return; }
        }
    }
}
constexpr int T_L0 = T_WIN + T_WOUT + T_FGU + T_FDN, T_L1 = T_WIN + T_WOUT + T_MGU + T_MDN;
constexpr int T_L1A = T_L0 + T_WIN + T_WOUT;
__device__ __forceinline__ void convert_layer1_weights(const Frame& F, int first_bid, int nblocks, int it_lo, int it_hi) {
    LAS float* scr = (LAS float*)(F.lds + F.wave * 16384);
    const int gw = (F.bid - first_bid) * NWAVES + F.wave, NGW = nblocks * NWAVES;
    for (int it = it_lo + gw; it < it_hi; it += NGW) weight_item(F, it, scr);
}
__device__ __forceinline__ void phase_p0(const Frame& F) {
    unsigned char* ws = F.ws;
    if (F.bid < 192) {
        LAS float* cond = (LAS float*)F.lds;
        LAS float* red = (LAS float*)(F.lds + 36864);
        for (int i = F.tid; i < 9 * 1024; i += NTHREADS) { const int r = i >> 10, k = i & 1023; const float c = r < 8 ? F.in(IN_C)[r * 1024 + k] : F.in(IN_CCTX)[k]; cond[i] = c * sigmoidf_(c); }
        __syncthreads();
        for (int it = F.bid; it < 192; it += F.G) {
            const int l = it / 96, col0 = (it % 96) * 64, c = F.tid & 63, kg = F.tid >> 6;
            float acc[9];
#pragma unroll
            for (int r = 0; r < 9; ++r) acc[r] = 0.f;
            const float* wp = F.in(IN_WADA) + ((size_t)l * 1024 + kg * 128) * 6144 + col0 + c;
#pragma unroll 4
            for (int k = 0; k < 128; ++k) { const float w = wp[(size_t)k * 6144];
#pragma unroll
                for (int r = 0; r < 9; ++r) acc[r] += cond[r * 1024 + kg * 128 + k] * w; }
#pragma unroll
            for (int r = 0; r < 9; ++r) red[(kg * 9 + r) * 64 + c] = acc[r];
            __syncthreads();
            for (int o = F.tid; o < 576; o += NTHREADS) { const int r = o >> 6, cc = o & 63; float s = F.in(IN_BADA)[l * 6144 + col0 + cc];
#pragma unroll
                for (int g = 0; g < 8; ++g) s += red[(g * 9 + r) * 64 + cc];
                ((float*)(ws + WS_MODF))[(l * 9 + r) * 6144 + col0 + cc] = s; }
            __syncthreads();
        }
    }
    { const int gid = F.bid * NTHREADS + F.tid;
      if (gid < 2048) { const int l = gid >> 10, dir = (gid >> 9) & 1, i = gid & 511; float v = 0.f;
          if (l == 1) { const float h0 = F.in(IN_HLB)[(0 * 2 + dir) * 512 + i], h1 = F.in(IN_HLB)[(1 * 2 + dir) * 512 + i]; v = 1.0f / (1.0f + __expf(h0 - h1)); }
          ((float*)(ws + WS_LBV))[gid] = v; }
      else if (gid < 2048 + 32768) { const int idx = gid - 2048, l = idx >> 14, g = (idx >> 10) & 15, k = idx & 1023;
          ((bf16*)(ws + WS_WG))[idx] = (bf16)f2bf(F.in(IN_WIN)[((size_t)l * 1024 + k) * PROJ + 3584 + g]); } }
}
__device__ __forceinline__ void convert_layer0_weights(const Frame& F) {
    __syncthreads();
    LAS float* scr = (LAS float*)(F.lds + F.wave * 16384);
    const int gw = F.bid * NWAVES + F.wave, NGW = F.G * NWAVES;
    for (int it = gw; it < T_WIN + T_WOUT; it += NGW) weight_item(F, it, scr);
}

struct RowVecs { f32x4 gate[4], lng[4], lnb[4], sc[4], sh[4]; };
struct RowIn { f32x4 v[4]; v2u xb[4], f1[4], f2[4]; f32x2 pp; };
template <bool HAS_BR, int MOE, bool XIN_BF = false>
__device__ __forceinline__ RowIn row_load(const Frame& F, const float* xrow, const bf16* frow, int rowid) {
    RowIn R;
    if (XIN_BF) { const GAS v2u* xr = (const GAS v2u*)xrow + F.lane;
#pragma unroll
        for (int j = 0; j < 4; ++j) R.xb[j] = xr[64 * j]; }
    else { const GAS f32x4* xr = (const GAS f32x4*)xrow + F.lane;
#pragma unroll
        for (int j = 0; j < 4; ++j) R.v[j] = xr[64 * j]; }
    if (HAS_BR && MOE != 2) { const GAS v2u* fr = (const GAS v2u*)frow + F.lane;
#pragma unroll
        for (int j = 0; j < 4; ++j) R.f1[j] = fr[64 * j]; }
    if (HAS_BR && MOE == 2) {
        const int s1 = __builtin_amdgcn_readfirstlane(((const int*)(F.ws + WS_TOKSLOT))[2 * rowid]), s2 = __builtin_amdgcn_readfirstlane(((const int*)(F.ws + WS_TOKSLOT))[2 * rowid + 1]);
        R.pp = ((const f32x2*)(F.ws + WS_TOPP))[rowid];
        const GAS v2u* f1 = (const GAS v2u*)(frow + (size_t)s1 * DM) + F.lane; const GAS v2u* f2 = (const GAS v2u*)(frow + (size_t)s2 * DM) + F.lane;
#pragma unroll
        for (int j = 0; j < 4; ++j) { R.f1[j] = f1[64 * j]; R.f2[j] = f2[64 * j]; } }
    return R;
}
template <bool HAS_BR, bool HAS_LN, bool HAS_XOUT, bool HAS_HX, int MOE, bool XIN_BF = false, bool XOUT_BF = false>
__device__ __forceinline__ int row_one(const Frame& F, const RowVecs& V, const RowIn& R, float* orow, bf16* hrow, int rowid, const LAS float* rw) {
    int te_ret = 0;
    f32x4 v[4];
#pragma unroll
    for (int j = 0; j < 4; ++j) { if (XIN_BF) { const v2u w = R.xb[j]; const f32x2 a = unh(w.x), c = unh(w.y); v[j] = (f32x4){a.x, a.y, c.x, c.y}; } else v[j] = R.v[j]; }
    if (HAS_BR && MOE != 2) {
#pragma unroll
        for (int j = 0; j < 4; ++j) { const v2u w = R.f1[j]; const f32x4 f = (f32x4){bf_lo(w.x), bf_hi(w.x), bf_lo(w.y), bf_hi(w.y)}; v[j] = v[j] * DN_ALPHA + V.gate[j] * f; }
    }
    if (HAS_BR && MOE == 2) {
#pragma unroll
        for (int j = 0; j < 4; ++j) { const v2u a = R.f1[j], c = R.f2[j];
            const f32x4 f = (f32x4){bf_lo(a.x), bf_hi(a.x), bf_lo(a.y), bf_hi(a.y)} * R.pp.x + (f32x4){bf_lo(c.x), bf_hi(c.x), bf_lo(c.y), bf_hi(c.y)} * R.pp.y; v[j] = v[j] * DN_ALPHA + V.gate[j] * f; }
    }
    if (HAS_LN) {
        float s = 0.f;
#pragma unroll
        for (int j = 0; j < 4; ++j) s += (v[j].x + v[j].y) + (v[j].z + v[j].w);
        const float mean = wave_sum(s) * (1.f / DM); float s2 = 0.f;
#pragma unroll
        for (int j = 0; j < 4; ++j) { v[j] = v[j] - mean; s2 += (v[j].x * v[j].x + v[j].y * v[j].y) + (v[j].z * v[j].z + v[j].w * v[j].w); }
        const float rstd = 1.0f / sqrtf(wave_sum(s2) * (1.f / DM) + LN_EPS);
#pragma unroll
        for (int j = 0; j < 4; ++j) v[j] = v[j] * rstd * V.lng[j] + V.lnb[j];
    }
    if (HAS_XOUT && XOUT_BF) { GAS v2u* o = (GAS v2u*)orow + F.lane;
#pragma unroll
        for (int j = 0; j < 4; ++j) { v2u w; w.x = pkh(v[j].x, v[j].y); w.y = pkh(v[j].z, v[j].w); o[64 * j] = w; } }
    if (HAS_XOUT && !XOUT_BF) { GAS f32x4* o = (GAS f32x4*)orow + F.lane;
#pragma unroll
        for (int j = 0; j < 4; ++j) o[64 * j] = v[j]; }
    if (HAS_HX) {
        f32x4 h[4];
#pragma unroll
        for (int j = 0; j < 4; ++j) h[j] = v[j] * (1.0f + V.sc[j]) + V.sh[j];
        GAS v2u* o = (GAS v2u*)hrow + F.lane;
#pragma unroll
        for (int j = 0; j < 4; ++j) { v2u w; w.x = pk2(h[j].x, h[j].y); w.y = pk2(h[j].z, h[j].w); o[64 * j] = w; }
        if (MOE == 1) {
            float lg[8];
#pragma unroll
            for (int e = 0; e < 8; ++e) lg[e] = 0.f;
#pragma unroll
            for (int j = 0; j < 4; ++j) { asm volatile("" ::: "memory");
#pragma unroll
                for (int q = 0; q < 4; ++q) { const int col = 4 * F.lane + 256 * j + q; const f32x4 w0 = *(const LAS f32x4*)(rw + col * 8), w1 = *(const LAS f32x4*)(rw + col * 8 + 4); const float hv = h[j][q];
                    lg[0] += hv * w0.x; lg[1] += hv * w0.y; lg[2] += hv * w0.z; lg[3] += hv * w0.w; lg[4] += hv * w1.x; lg[5] += hv * w1.y; lg[6] += hv * w1.z; lg[7] += hv * w1.w; } }
#pragma unroll
            for (int e = 0; e < 8; ++e) lg[e] = wave_sum(lg[e]) + F.in(IN_RB)[e];
            int e1 = 0; float v1 = lg[0];
#pragma unroll
            for (int e = 1; e < 8; ++e) if (lg[e] > v1) { v1 = lg[e]; e1 = e; }
            int e2 = -1; float v2 = -3.0e38f;
#pragma unroll
            for (int e = 0; e < 8; ++e) if (e != e1 && lg[e] > v2) { v2 = lg[e]; e2 = e; }
            const float p1 = 1.0f / (1.0f + __expf(v2 - v1));
            if (F.lane == 0) { ((int*)(F.ws + WS_TOPE))[rowid] = e1 | (e2 << 8); ((f32x2*)(F.ws + WS_TOPP))[rowid] = (f32x2){p1, 1.0f - p1}; }
            te_ret = e1 | (e2 << 8);
        }
    }
    return te_ret;
}
template <bool HAS_BR, bool HAS_LN, bool HAS_XOUT, bool HAS_HX, int MOE, bool XIN_BF = false, bool XOUT_BF = false>
__device__ __forceinline__ void row_phase(const Frame& F, int l, int sub, const float* xlat, const float* xctx, const bf16* fbr, float* olat, float* octx, bf16* hx, int hl, bool do_ctx) {
    const float* modf = (const float*)(F.ws + WS_MODF);
    const LAS float* rw = (const LAS float*)F.lds;
    if (MOE == 1) { for (int i = F.tid; i < 8192; i += NTHREADS) ((LAS float*)F.lds)[i] = F.in(IN_RW)[i]; __syncthreads(); }
    const int gidx = sub ? 5 : 2, shidx = sub ? 0 : 3;
#pragma unroll 1
    for (int seg = 0; seg < 2; ++seg) {
        if (seg == 1 && !do_ctx) break;
        const int r = seg ? 8 : (F.bid >> 5);
        RowVecs V;
#pragma unroll
        for (int j = 0; j < 4; ++j) { const int c = 4 * F.lane + 256 * j;
            V.gate[j] = HAS_BR ? *(const f32x4*)(modf + (l * 9 + r) * 6144 + gidx * 1024 + c) : (f32x4){0.f, 0.f, 0.f, 0.f};
            V.lng[j] = HAS_LN ? *(const f32x4*)(F.in(IN_LNG) + (l * 2 + sub) * 1024 + c) : (f32x4){0.f, 0.f, 0.f, 0.f};
            V.lnb[j] = HAS_LN ? *(const f32x4*)(F.in(IN_LNB) + (l * 2 + sub) * 1024 + c) : (f32x4){0.f, 0.f, 0.f, 0.f};
            V.sh[j] = HAS_HX ? *(const f32x4*)(modf + (hl * 9 + r) * 6144 + shidx * 1024 + c) : (f32x4){0.f, 0.f, 0.f, 0.f};
            V.sc[j] = HAS_HX ? *(const f32x4*)(modf + (hl * 9 + r) * 6144 + (shidx + 1) * 1024 + c) : (f32x4){0.f, 0.f, 0.f, 0.f}; }
        if (seg == 0) {
            int cnt[8];
#pragma unroll
            for (int e = 0; e < 8; ++e) cnt[e] = 0;
            const int row0 = F.bid * 128 + F.wave * 16; const bf16* fb0 = (MOE == 2) ? fbr : fbr + (size_t)row0 * DM; const size_t fstep = (MOE == 2) ? 0 : DM;
            RowIn RA = row_load<HAS_BR, MOE, XIN_BF>(F, xlat + (size_t)row0 * DM, fb0, row0), RB = row_load<HAS_BR, MOE, XIN_BF>(F, xlat + (size_t)(row0 + 1) * DM, fb0 + fstep, row0 + 1);
#pragma unroll 1
            for (int i = 0; i < 16; i += 2) {
#pragma unroll
                for (int ab = 0; ab < 2; ++ab) { const int row = row0 + i + ab;
                    const int te = row_one<HAS_BR, HAS_LN, HAS_XOUT, HAS_HX, MOE, XIN_BF, XOUT_BF>(F, V, ab ? RB : RA, olat + (size_t)row * DM, hx + (size_t)row * DM, row, rw);
                    if (i + 2 < 16) { if (ab) RB = row_load<HAS_BR, MOE, XIN_BF>(F, xlat + (size_t)(row + 2) * DM, fb0 + (size_t)(i + ab + 2) * fstep, row + 2); else RA = row_load<HAS_BR, MOE, XIN_BF>(F, xlat + (size_t)(row + 2) * DM, fb0 + (size_t)(i + ab + 2) * fstep, row + 2); }
                    if (MOE == 1) { const int e1 = __builtin_amdgcn_readfirstlane(te) & 255, e2 = __builtin_amdgcn_readfirstlane(te) >> 8;
#pragma unroll
                        for (int e = 0; e < 8; ++e) cnt[e] += (e1 == e ? 1 : 0) + (e2 == e ? 1 : 0); } } }
            if (MOE == 1) { int vsel = 0;
#pragma unroll
                for (int e = 0; e < 8; ++e) vsel = (F.lane == e) ? cnt[e] : vsel;
                if (F.lane < 8) ((int*)(F.ws + WS_WHIST))[(F.bid * 8 + F.wave) * 8 + F.lane] = vsel; }
        } else {
            const int cr = F.bid * 8 + F.wave, row = M_LAT + cr;
            const RowIn RC = row_load<HAS_BR, 0>(F, xctx + (size_t)cr * DM, fbr + (size_t)row * DM, row);
            row_one<HAS_BR, HAS_LN, HAS_XOUT, HAS_HX, 0>(F, V, RC, octx + (size_t)cr * DM, hx + (size_t)row * DM, row, rw);
        }
    }
}

typedef short bf16x8g __attribute__((ext_vector_type(8)));
__device__ __forceinline__ void gates_mfma(const Frame& F, int l, int first_bid, int nblocks, int grp0, int grp1) {
    const bf16* hx = (const bf16*)(F.ws + WS_A1); const bf16* wg = (const bf16*)(F.ws + WS_WG) + (size_t)l * 16 * 1024;
    float* gates = (float*)(F.ws + WS_GATES); const float* gb = F.in(IN_GBIAS) + l * 16;
    const int r16 = F.lane & 15, kq = F.lane >> 4; const float bias = gb[r16];
    for (int grp = grp0 + (F.bid - first_bid) * NWAVES + F.wave; grp < grp1; grp += nblocks * NWAVES) {
        const GAS v4u* ap = (const GAS v4u*)(hx + (size_t)(grp * 16 + r16) * DM + 8 * kq); const GAS v4u* bp = (const GAS v4u*)(wg + (size_t)r16 * DM + 8 * kq);
        f32x4 acc = {0.f, 0.f, 0.f, 0.f};
#pragma unroll 1
        for (int kb = 0; kb < 4; ++kb) { v4u a[8], b[8];
#pragma unroll
            for (int k = 0; k < 8; ++k) { a[k] = ap[(kb * 8 + k) * 4]; b[k] = bp[(kb * 8 + k) * 4]; }
#pragma unroll
            for (int k = 0; k < 8; ++k) acc = __builtin_amdgcn_mfma_f32_16x16x32_bf16(__builtin_bit_cast(bf16x8g, a[k]), __builtin_bit_cast(bf16x8g, b[k]), acc, 0, 0, 0); }
#pragma unroll
        for (int r = 0; r < 4; ++r) { float v = acc[r] + bias; if ((r16 >> 2) & 1) v = fminf(v, 0.f) - log1pf(__expf(-fabsf(v))); gates[(size_t)(grp * 16 + 4 * kq + r) * 16 + r16] = v; }
    }
}

__device__ __forceinline__ int chain_row(int b, int dir, int s, int i, bool& is_ctx, int& tglob) {
    const int t = dir ? 63 - i : i;
    if (s < 4) { is_ctx = true; const int ch = dir ? 3 - s : s; tglob = ch * 64 + t; return M_LAT + b * CTXL + ch * 64 + t; }
    is_ctx = false; const int ch = dir ? 67 - s : s - 4; tglob = t; return b * SEQ + ch * 64 + t;
}

__device__ __forceinline__ void phase_moe_dispatch(const Frame& F) {
    const int* whist = (const int*)(F.ws + WS_WHIST); int* slot_tok = (int*)(F.ws + WS_SLOTTOK); int* tok_slot = (int*)(F.ws + WS_TOKSLOT); int* meta = (int*)(F.ws + WS_META);
    LAS int* red = (LAS int*)F.lds;
    LAS int* fin = red + 128;
    LAS int* sbase = fin + 16;
    LAS int* segs = sbase + 8;
    const int gw0 = F.bid * 8;
    int all[8], pre[8];
#pragma unroll
    for (int e = 0; e < 8; ++e) { all[e] = 0; pre[e] = 0; }
#pragma unroll
    for (int k = 0; k < 4; ++k) { const int idx = F.tid + 512 * k; const v4u a = *(const GAS v4u*)(whist + idx * 8), c = *(const GAS v4u*)(whist + idx * 8 + 4); const int m = idx < gw0 ? 1 : 0;
        all[0] += a.x; all[1] += a.y; all[2] += a.z; all[3] += a.w; all[4] += c.x; all[5] += c.y; all[6] += c.z; all[7] += c.w;
        pre[0] += m * (int)a.x; pre[1] += m * (int)a.y; pre[2] += m * (int)a.z; pre[3] += m * (int)a.w; pre[4] += m * (int)c.x; pre[5] += m * (int)c.y; pre[6] += m * (int)c.z; pre[7] += m * (int)c.w; }
#pragma unroll
    for (int e = 0; e < 8; ++e) { all[e] = wave_sum_i(all[e]); pre[e] = wave_sum_i(pre[e]); }
    if (F.lane == 0) {
#pragma unroll
        for (int e = 0; e < 8; ++e) { red[F.wave * 16 + e] = all[e]; red[F.wave * 16 + 8 + e] = pre[e]; } }
    __syncthreads();
    if (F.tid < 16) { int s = 0;
#pragma unroll
        for (int w = 0; w < 8; ++w) s += red[w * 16 + F.tid];
        fin[F.tid] = s; }
    __syncthreads();
    if (F.tid == 0) { int acc = 0;
        for (int e = 0; e < 8; ++e) { segs[e] = acc; segs[8 + e] = fin[e]; sbase[e] = acc + fin[8 + e]; if (F.bid == 0) meta[e] = acc >> 8; acc += (fin[e] + 255) & ~255; }
        if (F.bid == 0) meta[8] = acc >> 8; }
    __syncthreads();
    if (F.bid == 0) {
        for (int e = 0; e < 8; ++e) { const int s0 = segs[e] + segs[8 + e], s1 = segs[e] + ((segs[8 + e] + 255) & ~255);
            for (int s = s0 + F.tid; s < s1; s += NTHREADS) slot_tok[s] = 0; } }
    int wb[8];
#pragma unroll
    for (int e = 0; e < 8; ++e) { int b = sbase[e];
        for (int w2 = 0; w2 < F.wave; ++w2) b += __builtin_amdgcn_readfirstlane(whist[(gw0 + w2) * 8 + e]);
        wb[e] = b; }
    const int* tope = (const int*)(F.ws + WS_TOPE);
#pragma unroll 1
    for (int i = 0; i < 16; ++i) { const int tok = F.bid * 128 + F.wave * 16 + i; const int te = __builtin_amdgcn_readfirstlane(tope[tok]); const int e1 = te & 255, e2 = te >> 8; int s1 = 0, s2 = 0;
#pragma unroll
        for (int e = 0; e < 8; ++e) { if (e1 == e) { s1 = wb[e]; wb[e] += 1; } if (e2 == e) { s2 = wb[e]; wb[e] += 1; } }
        if (F.lane == 0) { slot_tok[s1] = tok; slot_tok[s2] = tok; tok_slot[2 * tok] = s1; tok_slot[2 * tok + 1] = s2; } }
}

__device__ __forceinline__ void sub_barrier(unsigned* ctr, unsigned target, bool leader) {
    VM_WAIT(); __syncthreads();
    if (leader) { __builtin_amdgcn_fence(__ATOMIC_RELEASE, "agent"); asm volatile("s_waitcnt vmcnt(0)" ::: "memory");
        __hip_atomic_fetch_add(ctr, 1u, __ATOMIC_RELAXED, __HIP_MEMORY_SCOPE_AGENT);
        unsigned sp = 0; while (__hip_atomic_load(ctr, __ATOMIC_RELAXED, __HIP_MEMORY_SCOPE_AGENT) < target) { __builtin_amdgcn_s_sleep(1); if (++sp > (1u << 20)) break; }
        __builtin_amdgcn_fence(__ATOMIC_ACQUIRE, "agent"); asm volatile("s_waitcnt vmcnt(0)" ::: "memory"); }
    __syncthreads();
}
__device__ __forceinline__ void signal_counter(unsigned* ctr, bool leader) {
    VM_WAIT(); __syncthreads();
    if (leader) { __builtin_amdgcn_fence(__ATOMIC_RELEASE, "agent"); asm volatile("s_waitcnt vmcnt(0)" ::: "memory"); __hip_atomic_fetch_add(ctr, 1u, __ATOMIC_RELAXED, __HIP_MEMORY_SCOPE_AGENT); }
}
__device__ __forceinline__ void wait_counter(unsigned* ctr, unsigned target, bool leader) {
    if (leader) { unsigned sp = 0; while (__hip_atomic_load(ctr, __ATOMIC_RELAXED, __HIP_MEMORY_SCOPE_AGENT) < target) { __builtin_amdgcn_s_sleep(1); if (++sp > (1u << 20)) break; }
        __builtin_amdgcn_fence(__ATOMIC_ACQUIRE, "agent"); asm volatile("s_waitcnt vmcnt(0)" ::: "memory"); }
    __syncthreads();
}
__device__ __forceinline__ void final_phase(const Frame& F, int l, const float* xlat, const bf16* operm, float* olat, bool leader) {
    const float* modf = (const float*)(F.ws + WS_MODF); unsigned* ctl = (unsigned*)(F.ws + WS_CTL);
    const int P = __builtin_amdgcn_readfirstlane(((const int*)(F.ws + WS_META))[8]), G = F.G, nwu = 11 * P, nwd = 4 * P;
    const int ntu = nwu - (nwu / G) * G, frd = nwd / G, ntd = nwd - frd * G;
    const int cp = (F.bid + G - ntu) % G;
    wait_counter(ctl + CW_DFULL, (unsigned)G, leader);
    if (cp < ntd) return;
    int lo[8], hi[8];
    { const int q = nwd / 8, r = nwd % 8, thr = frd * (G / 8); int st = 0;
#pragma unroll
      for (int x = 0; x < 8; ++x) { const int sz = q + (x < r ? 1 : 0); lo[x] = (sz > thr) ? ((st + thr) >> 2) : (1 << 30); hi[x] = (sz > thr) ? ((st + sz - 1) >> 2) : -1; st += sz; } }
    const int nact = G - ntd, R = (M_LAT + nact * 8 - 1) / (nact * 8);
    const int r0 = ((cp - ntd) * 8 + F.wave) * R; int n = M_LAT - r0; n = n > R ? R : n;
    if (n <= 0) return;
    int p1 = -1, p2 = -1;
    if (F.lane < n) { p1 = ((const int*)(F.ws + WS_TOKSLOT))[2 * (r0 + F.lane)] >> 8; p2 = ((const int*)(F.ws + WS_TOKSLOT))[2 * (r0 + F.lane) + 1] >> 8; }
    bool dfr = false;
#pragma unroll
    for (int x = 0; x < 8; ++x) dfr = dfr || (p1 >= lo[x] && p1 <= hi[x]) || (p2 >= lo[x] && p2 <= hi[x]);
    unsigned mask = (unsigned)__builtin_amdgcn_readfirstlane((int)(unsigned)__ballot(dfr && F.lane < n));
    unsigned live = ((n >= 32) ? 0xffffffffu : ((1u << n) - 1u)) & ~mask;
    RowVecs V; int curb = r0 >> 12;
#pragma unroll
    for (int j = 0; j < 4; ++j) { const int c = 4 * F.lane + 256 * j;
        V.gate[j] = *(const f32x4*)(modf + (l * 9 + curb) * 6144 + 5 * 1024 + c);
        V.lng[j] = *(const f32x4*)(F.in(IN_LNG) + (l * 2 + 1) * 1024 + c); V.lnb[j] = *(const f32x4*)(F.in(IN_LNB) + (l * 2 + 1) * 1024 + c);
        V.sh[j] = (f32x4){0.f, 0.f, 0.f, 0.f}; V.sc[j] = (f32x4){0.f, 0.f, 0.f, 0.f}; }
#define FIN_POP(m_) ((m_) ? (int)__builtin_ctz(m_) : -1)
#define FIN_GATE(row_) do { const int b_ = (row_) >> 12; if (b_ != curb) { curb = b_; _Pragma("unroll") for (int j = 0; j < 4; ++j) V.gate[j] = *(const f32x4*)(modf + (l * 9 + curb) * 6144 + 5 * 1024 + 4 * F.lane + 256 * j); } } while (0)
#define FIN_LOAD(i_) row_load<true, 2, true>(F, xlat + (size_t)(r0 + (i_)) * DM, operm, r0 + (i_))
#define FIN_ONE(R_, i_) do { FIN_GATE(r0 + (i_)); row_one<true, true, true, false, 2, true, false>(F, V, R_, olat + (size_t)(r0 + (i_)) * DM, (bf16*)nullptr, r0 + (i_), (const LAS float*)F.lds); } while (0)
    int ia = FIN_POP(live); if (ia >= 0) live &= live - 1;
    int ib = FIN_POP(live); if (ib >= 0) live &= live - 1;
    RowIn RA, RB;
    if (ia >= 0) RA = FIN_LOAD(ia);
    if (ib >= 0) RB = FIN_LOAD(ib);
#pragma unroll 1
    for (;;) {
        if (ia < 0) break;
        FIN_ONE(RA, ia); ia = FIN_POP(live); if (ia >= 0) { live &= live - 1; RA = FIN_LOAD(ia); }
        if (ib < 0) break;
        FIN_ONE(RB, ib); ib = FIN_POP(live); if (ib >= 0) { live &= live - 1; RB = FIN_LOAD(ib); }
    }
    if (mask) {
        unsigned sp = 0;
        while ((unsigned)__builtin_amdgcn_readfirstlane(__hip_atomic_load(ctl + CW_DTAIL, __ATOMIC_RELAXED, __HIP_MEMORY_SCOPE_AGENT)) < (unsigned)ntd) { __builtin_amdgcn_s_sleep(2); if (++sp > (1u << 22)) break; }
        __builtin_amdgcn_fence(__ATOMIC_ACQUIRE, "agent"); asm volatile("s_waitcnt vmcnt(0)" ::: "memory");
#pragma unroll 1
        while (mask) { const int i = (int)__builtin_ctz(mask); mask &= mask - 1; const RowIn RC = FIN_LOAD(i); FIN_ONE(RC, i); }
    }
#undef FIN_POP
#undef FIN_GATE
#undef FIN_LOAD
#undef FIN_ONE
}

__device__ __forceinline__ void ctx_rows(const Frame& F, int l, int sub, const float* xctx, const bf16* fbr, float* octx, bf16* hxc, int hl, int sb, int nsb) {
    const float* modf = (const float*)(F.ws + WS_MODF); const int gidx = sub ? 5 : 2, shidx = sub ? 0 : 3, r = 8;
    RowVecs V;
#pragma unroll
    for (int j = 0; j < 4; ++j) { const int c = 4 * F.lane + 256 * j;
        V.gate[j] = *(const f32x4*)(modf + (l * 9 + r) * 6144 + gidx * 1024 + c);
        V.lng[j] = *(const f32x4*)(F.in(IN_LNG) + (l * 2 + sub) * 1024 + c); V.lnb[j] = *(const f32x4*)(F.in(IN_LNB) + (l * 2 + sub) * 1024 + c);
        V.sh[j] = *(const f32x4*)(modf + (hl * 9 + r) * 6144 + shidx * 1024 + c); V.sc[j] = *(const f32x4*)(modf + (hl * 9 + r) * 6144 + (shidx + 1) * 1024 + c); }
#pragma unroll 1
    for (int cr = sb * NWAVES + F.wave; cr < M_CTX; cr += nsb * NWAVES) {
        const RowIn RC = row_load<true, 0>(F, xctx + (size_t)cr * DM, fbr + (size_t)cr * DM, 0);
        row_one<true, true, true, true, 0>(F, V, RC, octx + (size_t)cr * DM, hxc + (size_t)cr * DM, 0, (const LAS float*)F.lds); }
}
__device__ __forceinline__ void ctx_rows4(const Frame& F, int l, int sub, const float* xctx, const bf16* f0, const bf16* f1, const bf16* f2, const bf16* f3, float* octx, bf16* hxc, int hl, int sb, int nsb) {
    const float* modf = (const float*)(F.ws + WS_MODF); const int gidx = sub ? 5 : 2, shidx = sub ? 0 : 3, r = 8;
    RowVecs V;
#pragma unroll
    for (int j = 0; j < 4; ++j) { const int c = 4 * F.lane + 256 * j;
        V.gate[j] = *(const f32x4*)(modf + (l * 9 + r) * 6144 + gidx * 1024 + c);
        V.lng[j] = *(const f32x4*)(F.in(IN_LNG) + (l * 2 + sub) * 1024 + c); V.lnb[j] = *(const f32x4*)(F.in(IN_LNB) + (l * 2 + sub) * 1024 + c);
        V.sh[j] = *(const f32x4*)(modf + (hl * 9 + r) * 6144 + shidx * 1024 + c); V.sc[j] = *(const f32x4*)(modf + (hl * 9 + r) * 6144 + (shidx + 1) * 1024 + c); }
#pragma unroll 1
    for (int cr = sb * NWAVES + F.wave; cr < M_CTX; cr += nsb * NWAVES) {
        RowIn RC; const GAS f32x4* xr = (const GAS f32x4*)(xctx + (size_t)cr * DM) + F.lane; const size_t fo = (size_t)cr * DM;
#pragma unroll
        for (int j = 0; j < 4; ++j) { const v2u a = ((const GAS v2u*)(f0 + fo) + F.lane)[64 * j], b2 = ((const GAS v2u*)(f1 + fo) + F.lane)[64 * j], c = ((const GAS v2u*)(f2 + fo) + F.lane)[64 * j], d = ((const GAS v2u*)(f3 + fo) + F.lane)[64 * j];
            const f32x4 f = ((f32x4){bf_lo(a.x), bf_hi(a.x), bf_lo(a.y), bf_hi(a.y)} + (f32x4){bf_lo(b2.x), bf_hi(b2.x), bf_lo(b2.y), bf_hi(b2.y)}) + ((f32x4){bf_lo(c.x), bf_hi(c.x), bf_lo(c.y), bf_hi(c.y)} + (f32x4){bf_lo(d.x), bf_hi(d.x), bf_lo(d.y), bf_hi(d.y)});
            RC.v[j] = xr[64 * j] * DN_ALPHA + V.gate[j] * f; }
        row_one<false, true, true, true, 0>(F, V, RC, octx + (size_t)cr * DM, hxc + (size_t)cr * DM, 0, (const LAS float*)F.lds); }
}
template <int PART>
__device__ __forceinline__ void ctx_pipeline(const Frame& F);
typedef short s16x4 __attribute__((ext_vector_type(4)));
typedef short bf16x8 __attribute__((ext_vector_type(8)));
typedef float f32x16 __attribute__((ext_vector_type(16)));
__device__ __forceinline__ unsigned off_b(unsigned row, unsigned ch) { return 256u * row + 16u * (ch ^ (((row & 3u) << 2) | ((row >> 2) & 3u))); }
__device__ __forceinline__ bf16x8 frag_row(LAS unsigned char* img, int row0, int s, int lane, int cb0 = 0) { return *(const LAS bf16x8*)(img + off_b(row0 + (lane & 31), cb0 + 2 * s + (lane >> 5))); }
__device__ __forceinline__ bf16x8 frag_tr(LAS unsigned char* img, int c, int ks, int lane) {
    const unsigned h = lane >> 5, blk = (lane >> 4) & 1, q = (lane & 15) >> 2, p = lane & 3;
    const unsigned a0 = off_b(16 * ks + 8 * h + q, 4 * c + 2 * blk + (p >> 1)) + 8 * (p & 1), a1 = off_b(16 * ks + 8 * h + 4 + q, 4 * c + 2 * blk + (p >> 1)) + 8 * (p & 1);
    const s16x4 lo = __builtin_amdgcn_ds_read_tr16_b64_v4i16((LAS s16x4*)(img + a0)), hi = __builtin_amdgcn_ds_read_tr16_b64_v4i16((LAS s16x4*)(img + a1));
    return __builtin_shufflevector(lo, hi, 0, 1, 2, 3, 4, 5, 6, 7);
}
#ifdef PROBE_NO_MFMA
#define MFMA32(a, b, c) (c)
#else
#ifdef PROBE_NO_MFMA
#define MFMA32(a, b, c) (c)
#else
#define MFMA32(a, b, c) __builtin_amdgcn_mfma_f32_32x32x16_bf16((a), (b), (c), 0, 0, 0)
#endif
#define LDS_BAR() do { asm volatile("s_waitcnt lgkmcnt(0)" ::: "memory"); __builtin_amdgcn_s_barrier(); asm volatile("" ::: "memory"); } while (0)
#define SEXP(x) __expf(x)
#endif
#define LDS_BAR() do { asm volatile("s_waitcnt lgkmcnt(0)" ::: "memory"); __builtin_amdgcn_s_barrier(); asm volatile("" ::: "memory"); } while (0)
#ifdef PROBE_NO_EXP
#define SEXP(x) ((x) * 0.5f + 1.0f)
#else
#define SEXP(x) __expf(x)
#endif
__device__ __forceinline__ f32x16 zero16() { f32x16 z; for (int i = 0; i < 16; ++i) z[i] = 0.f; return z; }
__device__ __forceinline__ void store_tile_T(LAS unsigned char* img, int col0, int rowchunk0, const f32x16& t, int lane) {
    const int c = col0 + (lane & 31), h = lane >> 5;
#pragma unroll
    for (int g = 0; g < 4; ++g) { v2u w; w.x = pk2(t[4 * g], t[4 * g + 1]); w.y = pk2(t[4 * g + 2], t[4 * g + 3]); *(LAS v2u*)(img + off_b(c, rowchunk0 + g) + 8 * h) = w; }
}
__device__ __forceinline__ unsigned scr_off(int row, int c) { return (unsigned)(row * 64 + (((c + (row >> 2)) & 3) << 4)); }
__device__ __forceinline__ float clamp80(float x) { return fminf(fmaxf(x, -80.f), 80.f); }
__device__ __forceinline__ int crow_of(int b, int dir, int s, int i) { bool ic; int tg; return chain_row(b, dir, s, i, ic, tg); }
__device__ __forceinline__ void ctx_combine(const Frame& F, int b, int ycol0, const float* normw, int zgcol0) {
    const bf16* cf = (const bf16*)(F.ws + WS_CFB); const bf16* cb = cf + (size_t)M_CTX * DM; const bf16* z = (const bf16*)(F.ws + WS_Z); bf16* y = (bf16*)(F.ws + WS_A1);
    const int c4 = (F.tid & 31) * 4; const f32x4 nw = *(const f32x4*)(normw + c4);
#pragma unroll 1
    for (int pass = 0; pass < 16; ++pass) { const int cr = b * CTXL + pass * 16 + (F.tid >> 5); const size_t o = (size_t)cr * DM + ycol0 + c4;
        const v2u a = *(const GAS v2u*)(cf + o), c = *(const GAS v2u*)(cb + o), g = *(const GAS v2u*)(z + (size_t)(M_LAT + cr) * ZLD + zgcol0 + c4);
        const float t0 = bf_lo(a.x) + bf_lo(c.x), t1 = bf_hi(a.x) + bf_hi(c.x), t2 = bf_lo(a.y) + bf_lo(c.y), t3 = bf_hi(a.y) + bf_hi(c.y);
        float ss = t0 * t0 + t1 * t1 + t2 * t2 + t3 * t3;
#pragma unroll
        for (int m = 1; m < 32; m <<= 1) ss += __shfl_xor(ss, m);
        const float rr = 1.0f / sqrtf(ss * (1.f / 128.f) + RMS_EPS);
        v2u w; w.x = pk2(t0 * rr * nw.x * bf_lo(g.x), t1 * rr * nw.y * bf_hi(g.x)); w.y = pk2(t2 * rr * nw.z * bf_lo(g.y), t3 * rr * nw.w * bf_hi(g.y));
        *(GAS v2u*)(y + (size_t)(M_LAT + cr) * DM + ycol0 + c4) = w; }
}

constexpr int HG_QT = 0, HG_QH = 16384, HG_KT = 32768, HG_VT = 49152, HG_AM = 65536, HG_SB = 81920, HG_TOT = 114688, HG_E1 = HG_TOT + 4096, HG_E2 = HG_E1 + 512, HG_SSQ = HG_E2 + 512;
__device__ __forceinline__ void hgrn_scan(const Frame& F, int l, int b, int h, int dir, int half, bool ctx_out) {
    const bf16* z = (const bf16*)(F.ws + WS_Z); bf16* y = (bf16*)(F.ws + WS_A1); bf16* craw = (bf16*)(F.ws + WS_CFB) + (size_t)dir * M_CTX * DM;
    LAS unsigned char* lds = F.lds;
    LAS float* tot = (LAS float*)(lds + HG_TOT); LAS float* e1t = (LAS float*)(lds + HG_E1); LAS float* e2t = (LAS float*)(lds + HG_E2); LAS float* ssq = (LAS float*)(lds + HG_SSQ);
    const int tid = F.tid, lane = F.lane, wv = F.wave, cp = tid & 63, lh = lane >> 5, l31 = lane & 31;
    const int tvo = wv >> 1, ti = wv & 1;
    const int td = wv >> 1, tv0 = 2 * (wv & 1);
    const int ycol0 = h * 128, zq = ZC_HQ + h * 128, zf = (dir ? ZC_HF1 : ZC_HF0) + h * 128, zv = ZC_HI + h * 128, zg = ZC_HG + h * 128;
    float* st = (float*)(F.ws + WS_STATE) + (size_t)F.bid * 32768 + ((size_t)(wv * 2) * 64 + lane) * 16;
    f32x16 S0, S1;
    if (half == 0) { S0 = zero16(); S1 = zero16(); }
    else { for (int q4 = 0; q4 < 4; ++q4) { const f32x4 a = *(const GAS f32x4*)(st + 4 * q4), c = *(const GAS f32x4*)(st + 1024 + 4 * q4); for (int e = 0; e < 4; ++e) { S0[4 * q4 + e] = a[e]; S1[4 * q4 + e] = c[e]; } } }
    store_tile_T(lds + HG_SB, 32 * tv0, 4 * td, S0, lane); store_tile_T(lds + HG_SB, 32 * (tv0 + 1), 4 * td, S1, lane);
    const float* const nwp = F.in(IN_HGNORM) + (l * 4 + h) * 128 + 32 * tvo + 4 * lh;
    if (half == 1) {
        (void)ctx_out;
    }
    const int s_beg = half ? 36 : 0, s_end = half ? 68 : 36;
    unsigned qreg[8], freg[8]; v4u vreg[2];
    const int sgn = dir ? -1 : 1, t0 = dir ? 63 : 0;
    const unsigned voff_qf = 4u * (unsigned)cp;
    const unsigned voff_v = (unsigned)(((dir ? 3 - (lane >> 4) : (lane >> 4)) * ZLD + (tid & 15) * 8) * 2);
#define HG_RB(s_) (((s_) < 4) ? M_LAT + b * CTXL + (dir ? 3 - (s_) : (s_)) * 64 : b * SEQ + (dir ? 67 - (s_) : (s_) - 4) * 64)
#ifdef PROBE_SAME_ROWS
#define HG_RBL(s_) (b * SEQ + ((s_) & 1) * 64)
#else
#define HG_RBL(s_) HG_RB(s_)
#endif
#define HG_LOAD(s_) do { const int rb_ = HG_RBL(s_); \
        _Pragma("unroll") for (int p = 0; p < 8; ++p) { const GAS char* zr = (const GAS char*)(z + (size_t)(rb_ + t0 + sgn * (8 * wv + p)) * ZLD); \
            qreg[p] = *(const GAS unsigned*)(zr + 2 * zq + voff_qf); freg[p] = *(const GAS unsigned*)(zr + 2 * zf + voff_qf); } \
        _Pragma("unroll") for (int k2 = 0; k2 < 2; ++k2) { const GAS char* zr = (const GAS char*)(z + (size_t)(rb_ + t0 + sgn * (4 * wv + 32 * k2) - (dir ? 3 : 0)) * ZLD + zv); \
            vreg[k2] = *(const GAS v4u*)(zr + voff_v); } } while (0)
    HG_LOAD(s_beg);
    LDS_BAR();
#ifdef PROBE_SEC
    unsigned long long sec_acc = 0, sec_t0 = 0;
#define SEC(k) do { const unsigned long long t_ = __builtin_amdgcn_s_memtime(); if ((k) == PROBE_SEC) sec_t0 = t_; if ((k) == PROBE_SEC + 1 || (PROBE_SEC == 4 && (k) == 0 && sec_t0 != 0)) sec_acc += t_ - sec_t0; } while (0)
#else
#define SEC(k) do {} while (0)
#endif
#pragma unroll 1
    for (int s = s_beg; s < s_end; ++s) {
        SEC(0);
        f32x2 gl[8]; f32x2 run = {0.f, 0.f};
#pragma unroll
        for (int p = 0; p < 8; ++p) { run += (f32x2){bf_lo(freg[p]), bf_hi(freg[p])}; gl[p] = run; }
        *(LAS f32x2*)(tot + wv * 128 + 2 * cp) = run;
#pragma unroll
        for (int k2 = 0; k2 < 2; ++k2) { const int idx = tid + 512 * k2; *(LAS v4u*)(lds + HG_VT + off_b(idx >> 4, idx & 15)) = vreg[k2]; }
        LDS_BAR();
        SEC(1);
        f32x2 pre = {0.f, 0.f}, gr = {0.f, 0.f};
#pragma unroll
        for (int w2 = 0; w2 < 4; ++w2) { const f32x2 t2 = *(const LAS f32x2*)(tot + w2 * 128 + 2 * cp); gr += t2; if (w2 < wv) pre += t2; }
#pragma unroll
        for (int w2 = 4; w2 < 7; ++w2) { if (w2 < wv) pre += *(const LAS f32x2*)(tot + w2 * 128 + 2 * cp); }
        const f32x2 egr = {__builtin_amdgcn_exp2f(gr.x), __builtin_amdgcn_exp2f(gr.y)};
        if (wv == 0) { f32x2 gt2 = {0.f, 0.f};
#pragma unroll
            for (int w2 = 4; w2 < 8; ++w2) gt2 += *(const LAS f32x2*)(tot + w2 * 128 + 2 * cp);
            *(LAS f32x2*)(e1t + 2 * cp) = egr; *(LAS f32x2*)(e2t + 2 * cp) = (f32x2){__builtin_amdgcn_exp2f(gt2.x), __builtin_amdgcn_exp2f(gt2.y)}; }
        pre -= gr;
        const unsigned xw = (unsigned)(2 * wv);
#pragma unroll
        for (int p = 0; p < 8; ++p) { const f32x2 d = pre + gl[p];
            const f32x2 E1 = {__builtin_amdgcn_exp2f(__builtin_amdgcn_fmed3f(d.x, -115.f, 115.f)), __builtin_amdgcn_exp2f(__builtin_amdgcn_fmed3f(d.y, -115.f, 115.f))};
            const f32x2 R1 = {__builtin_amdgcn_rcpf(E1.x), __builtin_amdgcn_rcpf(E1.y)};
            const f32x2 kk = (f32x2){1.0f, 1.0f} - (f32x2){__builtin_amdgcn_exp2f(bf_lo(freg[p])), __builtin_amdgcn_exp2f(bf_hi(freg[p]))};
            const f32x2 qt = (f32x2){bf_lo(qreg[p]), bf_hi(qreg[p])} * E1, qh = qt * egr, kt = kk * R1;
            const unsigned xr = (((unsigned)p & 3u) << 2) | ((xw + ((unsigned)p >> 2)) & 3u);
            const unsigned o = 256u * (unsigned)(8 * wv + p) + 16u * (((unsigned)cp >> 2) ^ xr) + ((unsigned)cp & 3u) * 4u;
            *(LAS unsigned*)(lds + HG_QT + o) = pk2(qt.x, qt.y);
            *(LAS unsigned*)(lds + HG_QH + o) = pk2(qh.x, qh.y);
            *(LAS unsigned*)(lds + HG_KT + o) = pk2(kt.x, kt.y); }
#ifndef PROBE_NO_LOAD
        if (half == 0 && s + 1 == 4 + 4 * IP_K(l)) wait_counter((unsigned*)(F.ws + WS_CTL) + CW_IP2 + 64 * l, 128u, tid == 0);
        if (s + 1 < s_end) HG_LOAD(s + 1);
#endif
        const bool octx = s < 4;
        int orow2[2];
#pragma unroll
        for (int rep = 0; rep < 2; ++rep) orow2[rep] = HG_RB(s) + t0 + sgn * (32 * ti + 16 * rep) + sgn * (lane >> 2);
        v4u rov[2], gtv[2];
        if (half == 1) {
#pragma unroll
            for (int rep = 0; rep < 2; ++rep) { rov[rep] = *(const GAS v4u*)(y + (size_t)orow2[rep] * DM + ycol0 + 32 * tvo + 8 * (lane & 3)); gtv[rep] = *(const GAS v4u*)(z + (size_t)orow2[rep] * ZLD + zg + 32 * tvo + 8 * (lane & 3)); }
        }
        LAS unsigned char* const scrA = lds + HG_QT + wv * 2048; LAS unsigned char* const scrB = lds + HG_AM + wv * 2048;
        LDS_BAR();
        SEC(2);
        f32x16 O = zero16();
#pragma unroll
        for (int kb = 0; kb < 2; ++kb) { bf16x8 fa[4], fb[4];
#pragma unroll
          for (int k4 = 0; k4 < 4; ++k4) { fa[k4] = frag_row(lds + HG_SB, 32 * tvo, 4 * kb + k4, lane); fb[k4] = frag_row(lds + HG_QH, 32 * ti, 4 * kb + k4, lane); }
#pragma unroll
          for (int k4 = 0; k4 < 4; ++k4) O = MFMA32(fa[k4], fb[k4], O); }
        if (wv < 3) { const int tj = wv >> 1, tia = (wv + 1) >> 1; f32x16 P = zero16();
#pragma unroll
            for (int kb = 0; kb < 2; ++kb) { bf16x8 fa[4], fb[4];
#pragma unroll
              for (int k4 = 0; k4 < 4; ++k4) { fa[k4] = frag_row(lds + HG_KT, 32 * tj, 4 * kb + k4, lane); fb[k4] = frag_row(lds + HG_QT, 32 * tia, 4 * kb + k4, lane); }
#pragma unroll
              for (int k4 = 0; k4 < 4; ++k4) P = MFMA32(fa[k4], fb[k4], P); }
            const int ii = 32 * tia + l31;
#pragma unroll
            for (int r = 0; r < 16; ++r) { const int jj = 32 * tj + (r & 3) + 8 * (r >> 2) + 4 * lh; if (jj > ii) P[r] = 0.f; }
            store_tile_T(lds + HG_AM, 32 * tia, 4 * tj, P, lane); }
        LDS_BAR();
        SEC(3);
        if (half == 1) {
#pragma unroll
            for (int rep = 0; rep < 2; ++rep) *(LAS v4u*)(scrA + scr_off((lane >> 2) + 16 * rep, lane & 3)) = rov[rep]; }
        { f32x4 e1v[4], e2v[4];
#pragma unroll
          for (int g = 0; g < 4; ++g) { e1v[g] = *(const LAS f32x4*)(e1t + 32 * td + 8 * g + 4 * lh); e2v[g] = *(const LAS f32x4*)(e2t + 32 * td + 8 * g + 4 * lh); }
#pragma unroll
          for (int r = 0; r < 16; ++r) { S0[r] *= e1v[r >> 2][r & 3]; S1[r] *= e1v[r >> 2][r & 3]; }
          { bf16x8 ka[4], v0[4], v1[4];
#pragma unroll
            for (int ks = 0; ks < 4; ++ks) { ka[ks] = frag_tr(lds + HG_KT, td, ks, lane); v0[ks] = frag_tr(lds + HG_VT, tv0, ks, lane); v1[ks] = frag_tr(lds + HG_VT, tv0 + 1, ks, lane); }
#pragma unroll
            for (int ks = 0; ks < 4; ++ks) { S0 = MFMA32(ka[ks], v0[ks], S0); S1 = MFMA32(ka[ks], v1[ks], S1); } }
#pragma unroll
          for (int r = 0; r < 16; ++r) { S0[r] *= e2v[r >> 2][r & 3]; S1[r] *= e2v[r >> 2][r & 3]; }
          store_tile_T(lds + HG_SB, 32 * tv0, 4 * td, S0, lane); store_tile_T(lds + HG_SB, 32 * (tv0 + 1), 4 * td, S1, lane); }
        { bf16x8 fa[4], fb[4];
#pragma unroll
          for (int ks = 0; ks < 4; ++ks) { fa[ks] = frag_tr(lds + HG_VT, tvo, ks, lane); fb[ks] = frag_row(lds + HG_AM, 32 * ti, ks, lane); }
#pragma unroll
          for (int ks = 0; ks < 4; ++ks) if (ks < 2 || ti == 1) O = MFMA32(fa[ks], fb[ks], O); }
        SEC(4);
        if (half == 0) {
#pragma unroll
            for (int g = 0; g < 4; ++g) { v2u w; w.x = pk2(O[4 * g], O[4 * g + 1]); w.y = pk2(O[4 * g + 2], O[4 * g + 3]); *(LAS v2u*)(scrA + scr_off(l31, g) + 8 * lh) = w; }
#pragma unroll
            for (int rep = 0; rep < 2; ++rep) { const v4u w = *(const LAS v4u*)(scrA + scr_off((lane >> 2) + 16 * rep, lane & 3));
                bf16* dst = octx ? craw + (size_t)(orow2[rep] - M_LAT) * DM : y + (size_t)orow2[rep] * DM;
#ifdef PROBE_NO_STORE
                if (w.x == 0x12345678u)
#endif
                *(GAS v4u*)(dst + ycol0 + 32 * tvo + 8 * (lane & 3)) = w; }
            LDS_BAR();
        } else {
            float ss = 0.f;
#pragma unroll
            for (int g = 0; g < 4; ++g) { const v2u r2 = *(const LAS v2u*)(scrA + scr_off(l31, g) + 8 * lh); O[4 * g] += bf_lo(r2.x); O[4 * g + 1] += bf_hi(r2.x); O[4 * g + 2] += bf_lo(r2.y); O[4 * g + 3] += bf_hi(r2.y); }
#pragma unroll
            for (int r = 0; r < 16; ++r) ss += O[r] * O[r];
            ss += __shfl_xor(ss, 32);
            const int ii2 = 32 * ti + l31;
            if (lh == 0) ssq[tvo * 64 + ii2] = ss;
            LDS_BAR();
#pragma unroll
            for (int rep = 0; rep < 2; ++rep) *(LAS v4u*)(scrB + scr_off((lane >> 2) + 16 * rep, lane & 3)) = gtv[rep];
            const float tss = (ssq[ii2] + ssq[64 + ii2]) + (ssq[128 + ii2] + ssq[192 + ii2]), rr = __builtin_amdgcn_rsqf(tss * (1.f / 128.f) + RMS_EPS);
            v2u yw[4];
#pragma unroll
            for (int g = 0; g < 4; ++g) { const v2u g2 = *(const LAS v2u*)(scrB + scr_off(l31, g) + 8 * lh); const f32x4 nv = *(const f32x4*)(nwp + 8 * g);
                yw[g].x = pk2(O[4 * g] * rr * nv.x * bf_lo(g2.x), O[4 * g + 1] * rr * nv.y * bf_hi(g2.x)); yw[g].y = pk2(O[4 * g + 2] * rr * nv.z * bf_lo(g2.y), O[4 * g + 3] * rr * nv.w * bf_hi(g2.y)); }
#pragma unroll
            for (int g = 0; g < 4; ++g) *(LAS v2u*)(scrB + scr_off(l31, g) + 8 * lh) = yw[g];
#pragma unroll
            for (int rep = 0; rep < 2; ++rep) { const v4u w = *(const LAS v4u*)(scrB + scr_off((lane >> 2) + 16 * rep, lane & 3)); *(GAS v4u*)(y + (size_t)orow2[rep] * DM + ycol0 + 32 * tvo + 8 * (lane & 3)) = w; }
        }
        if (half == 0 && s == 3 && ctx_out) signal_counter((unsigned*)(F.ws + WS_CTL) + CW_CC, tid == 0);
    }
#ifdef PROBE_SEC
    if (F.bid == 0 && tid == 0 && l == 0 && half == 0) ((LAS unsigned long long*)(F.lds + LDSCTL_OFF + 2048))[40] = sec_acc;
#endif
#undef SEC
#undef HG_LOAD
    if (half == 0) { for (int q4 = 0; q4 < 4; ++q4) { *(GAS f32x4*)(st + 4 * q4) = (f32x4){S0[4 * q4], S0[4 * q4 + 1], S0[4 * q4 + 2], S0[4 * q4 + 3]}; *(GAS f32x4*)(st + 1024 + 4 * q4) = (f32x4){S1[4 * q4], S1[4 * q4 + 1], S1[4 * q4 + 2], S1[4 * q4 + 3]}; } }
}

constexpr int ML_T1 = 0, ML_T2 = 16384, ML_VT = 32768, ML_PM = 49152, ML_CB = 65536, ML_TAB = 98304;
__device__ __forceinline__ void mlstm_scan(const Frame& F, int l, int b, int h, int dir, int half, bool ctx_out) {
    const bf16* z = (const bf16*)(F.ws + WS_Z); bf16* y = (bf16*)(F.ws + WS_A1); bf16* craw = (bf16*)(F.ws + WS_CFB) + (size_t)dir * M_CTX * DM; const float* gates = (const float*)(F.ws + WS_GATES);
    LAS unsigned char* lds = F.lds;
    LAS float* const tab0 = (LAS float*)(lds + ML_TAB);
    LAS float* ta = tab0;
    LAS float* trs = ta + 384;   LAS float* tn = ta + 512; LAS float* ssq = ta + 640;   LAS float* tnp = ta + 896;   LAS float* tqp = ta + 1408;
    const int tid = F.tid, lane = F.lane, wv = F.wave, cp = tid & 63, lh = lane >> 5, l31 = lane & 31;
    const int tvo = wv >> 1, ti = wv & 1;
    const int td = wv >> 2, tvc = wv & 3;
    const int ycol0 = 512 + h * 128, zv = ZC_MV + h * 128, zg = ZC_MO + h * 128;
    const bool isq = cp < 32; const int c2 = 2 * cp;
    const int chan = isq ? h * 64 + c2 : 256 + h * 64 + (c2 - 64), zqk = ZC_MQ + chan;
    const float* cw = F.in(IN_CONVW) + l * 1536 + chan; const float* cbp = F.in(IN_CONVB) + l * 512 + chan;
    const f32x2 w0 = *(const f32x2*)cw, w1 = *(const f32x2*)(cw + 512), w2 = *(const f32x2*)(cw + 1024), cbias = *(const f32x2*)cbp;
    float* st = (float*)(F.ws + WS_STATE) + (size_t)F.bid * 32768;
    f32x16 C; float mprev = 0.f;
    if (half == 0) { C = zero16(); if (tid < 64) { tn[tid] = 0.f; } }
    else { const float* sp = st + ((size_t)wv * 64 + lane) * 16;
        for (int q4 = 0; q4 < 4; ++q4) { const f32x4 a = *(const GAS f32x4*)(sp + 4 * q4); for (int e = 0; e < 4; ++e) C[4 * q4 + e] = a[e]; }
        if (tid < 64) tn[tid] = st[8192 + tid];
        mprev = st[8192 + 64]; }
    if (tid < 128) trs[tid] = 0.f;
    store_tile_T(lds + ML_CB, 32 * tvc, 4 * td, C, lane);
    const float* const nwp = F.in(IN_MLNORM) + (l * 4 + h) * 128 + 32 * tvo + 4 * lh;
    if (half == 1) {
        (void)ctx_out;
    }
    const int s_beg = half ? 36 : 0, s_end = half ? 68 : 36;
    unsigned ureg[10]; v4u vreg[2]; float gli = 0.f, glf = 0.f;
#define ML_LOAD(s_) do { const int s__ = (s_); const bool cx = s__ < 4; const int chk = cx ? (dir ? 3 - s__ : s__) : (dir ? 67 - s__ : s__ - 4); \
        const int rb = cx ? M_LAT + b * CTXL + chk * 64 : b * SEQ + chk * 64; const int tlo = dir ? 56 - 8 * wv : 8 * wv; \
        _Pragma("unroll") for (int m = 0; m < 10; ++m) { const int t = tlo - 1 + m; const int tg = cx ? chk * 64 + t : t; const bool ok = cx ? (tg >= 0 && tg < CTXL) : (t >= 0 && t < 64); \
            ureg[m] = ok ? *(const GAS unsigned*)(z + (size_t)(rb + t) * ZLD + zqk) : 0u; } \
        _Pragma("unroll") for (int k2 = 0; k2 < 2; ++k2) { const GAS char* zr_ = (const GAS char*)(z + (size_t)(rb + (dir ? 63 : 0) + (dir ? -1 : 1) * (4 * wv + 32 * k2) - (dir ? 3 : 0)) * ZLD + zv); \
            vreg[k2] = *(const GAS v4u*)(zr_ + (unsigned)(((dir ? 3 - (lane >> 4) : (lane >> 4)) * ZLD + (tid & 15) * 8) * 2)); } \
        if (wv == 7) { const float* gp = gates + (size_t)crow_of(b, dir, s__, lane) * 16 + dir * 8 + h; gli = gp[0]; glf = gp[4]; } } while (0)
#define ML_GATES(s_) do { LAS float* tg_ = tab0 + ((s_) & 1) * 1920; float bb = wave_scan_add(glf); \
        const float aa = gli - bb; float am = wave_scan_max(aa); \
        const float mu = fmaxf(am, mprev), mu63 = __builtin_bit_cast(float, __builtin_amdgcn_readlane(__builtin_bit_cast(int, mu), 63)), b63 = __builtin_bit_cast(float, __builtin_amdgcn_readlane(__builtin_bit_cast(int, bb), 63)); \
        tg_[lane] = aa; tg_[64 + lane] = mu; tg_[128 + lane] = __expf(aa - mu63); tg_[192 + lane] = __expf(mprev - mu); tg_[256 + lane] = __expf(fminf(-(bb + mu), 80.f)); \
        if (lane == 0) tg_[320] = __expf(mprev - mu63); \
        mprev = b63 + mu63; } while (0)
    ML_LOAD(s_beg);
    if (wv == 7) ML_GATES(s_beg);
    LDS_BAR();
#ifdef PROBE_MSEC
    unsigned long long msec_acc = 0, msec_t0 = 0;
#define MSEC(k) do { const unsigned long long t_ = __builtin_amdgcn_s_memtime(); if ((k) == PROBE_MSEC) msec_t0 = t_; if ((k) == PROBE_MSEC + 1 || (PROBE_MSEC == 4 && (k) == 0 && msec_t0 != 0)) msec_acc += t_ - msec_t0; } while (0)
#else
#define MSEC(k) do {} while (0)
#endif
#pragma unroll 1
    for (int s = s_beg; s < s_end; ++s) {
        MSEC(0);
        ta = tab0 + (s & 1) * 1920; LAS float* const tmu = ta + 64; LAS float* const twk = ta + 128; LAS float* const twi = ta + 192; LAS float* const temi = ta + 256; LAS float* const tsc = ta + 320;
        float kv0[8], kv1[8];
#pragma unroll
        for (int p = 0; p < 8; ++p) { const int i = 8 * wv + p; const unsigned up = dir ? ureg[7 - p] : ureg[p], uc = dir ? ureg[8 - p] : ureg[p + 1], un = dir ? ureg[9 - p] : ureg[p + 2];
            const float c0 = cbias.x + w0.x * bf_lo(up) + w1.x * bf_lo(uc) + w2.x * bf_lo(un), c1 = cbias.y + w0.y * bf_hi(up) + w1.y * bf_hi(uc) + w2.y * bf_hi(un);
            float s0 = c0 * __builtin_amdgcn_rcpf(1.0f + __builtin_amdgcn_exp2f(-1.44269504f * c0)), s1 = c1 * __builtin_amdgcn_rcpf(1.0f + __builtin_amdgcn_exp2f(-1.44269504f * c1));
            if (isq) { s0 *= 0.125f; s1 *= 0.125f; }
            kv0[p] = s0; kv1[p] = s1;
            *(LAS unsigned*)(lds + ML_T1 + off_b(i, cp >> 2) + (cp & 3) * 4) = pk2(s0, s1); }
#pragma unroll
        for (int k2 = 0; k2 < 2; ++k2) { const int idx = tid + 512 * k2; *(LAS v4u*)(lds + ML_VT + off_b(idx >> 4, idx & 15)) = vreg[k2]; }
        if (half == 0 && s + 1 == 4 + 4 * IP_K(l)) wait_counter((unsigned*)(F.ws + WS_CTL) + CW_IP2 + 64 * l, 128u, tid == 0);
        if (s + 1 < s_end) ML_LOAD(s + 1);
        const int orow = crow_of(b, dir, s, 32 * ti + l31); const bool octx = s < 4;
        int orow2[2];
#pragma unroll
        for (int rep = 0; rep < 2; ++rep) orow2[rep] = crow_of(b, dir, s, 32 * ti + (lane >> 2) + 16 * rep);
        v4u rov[2], gtv[2];
        if (half == 1) {
#pragma unroll
            for (int rep = 0; rep < 2; ++rep) { rov[rep] = *(const GAS v4u*)(y + (size_t)orow2[rep] * DM + ycol0 + 32 * tvo + 8 * (lane & 3)); gtv[rep] = *(const GAS v4u*)(z + (size_t)orow2[rep] * ZLD + zg + 32 * tvo + 8 * (lane & 3)); }
        }
        LAS unsigned char* const scrA = lds + ML_T1 + wv * 2048; LAS unsigned char* const scrB = lds + ML_PM + wv * 2048;
        LDS_BAR();
        MSEC(1);
        if (!isq) {
            float ps0 = 0.f, ps1 = 0.f;
#pragma unroll
            for (int p = 0; p < 8; ++p) { const int i = 8 * wv + p; const float wk = twk[i]; const unsigned pk = pk2(kv0[p] * wk, kv1[p] * wk); ps0 += bf_lo(pk); ps1 += bf_hi(pk);
                *(LAS unsigned*)(lds + ML_T2 + off_b(i, (cp - 32) >> 2) + (cp & 3) * 4) = pk; }
            *(LAS f32x2*)(tnp + wv * 64 + (c2 - 64)) = (f32x2){ps0, ps1};
        }
        {
            const v4u qv = *(const LAS v4u*)(lds + ML_T1 + off_b(lane, wv)); const f32x4 n0 = *(const LAS f32x4*)(tn + 8 * wv), n1 = *(const LAS f32x4*)(tn + 8 * wv + 4);
            tqp[wv * 64 + lane] = bf_lo(qv.x) * n0.x + bf_hi(qv.x) * n0.y + bf_lo(qv.y) * n0.z + bf_hi(qv.y) * n0.w + bf_lo(qv.z) * n1.x + bf_hi(qv.z) * n1.y + bf_lo(qv.w) * n1.z + bf_hi(qv.w) * n1.w;
        }
        LDS_BAR();
        MSEC(2);
        if (wv == 7 && s + 1 < s_end) ML_GATES(s + 1);
        const int ii = 32 * ti + l31;
        f32x16 H = zero16();
        { bf16x8 fa[4], fb[4];
#pragma unroll
          for (int k4 = 0; k4 < 4; ++k4) { fa[k4] = frag_row(lds + ML_CB, 32 * tvo, k4, lane); fb[k4] = frag_row(lds + ML_T1, 32 * ti, k4, lane); }
#pragma unroll
          for (int k4 = 0; k4 < 4; ++k4) H = MFMA32(fa[k4], fb[k4], H); }
        { const float wi = twi[ii];
#pragma unroll
          for (int r = 0; r < 16; ++r) H[r] *= wi; }
        if (wv < 3) { const int tj = wv >> 1, tia = (wv + 1) >> 1; f32x16 P = zero16();
            { bf16x8 fa[4], fb[4];
#pragma unroll
              for (int k4 = 0; k4 < 4; ++k4) { fa[k4] = frag_row(lds + ML_T1, 32 * tj, k4, lane, 8); fb[k4] = frag_row(lds + ML_T1, 32 * tia, k4, lane); }
#pragma unroll
              for (int k4 = 0; k4 < 4; ++k4) P = MFMA32(fa[k4], fb[k4], P); }
            const int ia = 32 * tia + l31; const float mui = tmu[ia]; float rs = 0.f;
#pragma unroll
            for (int g = 0; g < 4; ++g) { const f32x4 av = *(const LAS f32x4*)(ta + 32 * tj + 8 * g + 4 * lh);
#pragma unroll
                for (int e = 0; e < 4; ++e) { const int r = 4 * g + e, jj = 32 * tj + 8 * g + 4 * lh + e; const float pv = (jj > ia) ? 0.f : P[r] * __expf(av[e] - mui); P[r] = pv; rs += pv; } }
            rs += __shfl_xor(rs, 32);
            if (lh == 0) trs[tj * 64 + ia] = rs;
            store_tile_T(lds + ML_PM, 32 * tia, 4 * tj, P, lane); }
        LDS_BAR();
        MSEC(3);
        if (half == 1) {
#pragma unroll
            for (int rep = 0; rep < 2; ++rep) *(LAS v4u*)(scrA + scr_off((lane >> 2) + 16 * rep, lane & 3)) = rov[rep]; }
        { const float dec = tsc[0];
#pragma unroll
          for (int r = 0; r < 16; ++r) C[r] *= dec;
          { bf16x8 fa[4], fb[4];
#pragma unroll
            for (int ks = 0; ks < 4; ++ks) { fa[ks] = frag_tr(lds + ML_T2, td, ks, lane); fb[ks] = frag_tr(lds + ML_VT, tvc, ks, lane); }
#pragma unroll
            for (int ks = 0; ks < 4; ++ks) C = MFMA32(fa[ks], fb[ks], C); }
          store_tile_T(lds + ML_CB, 32 * tvc, 4 * td, C, lane);
          if (tid < 64) {
              float acc = 0.f;
#pragma unroll
              for (int w2 = 0; w2 < 8; ++w2) acc += tnp[w2 * 64 + tid];
              tn[tid] = dec * tn[tid] + acc; } }
        { bf16x8 fa[4], fb[4];
#pragma unroll
          for (int ks = 0; ks < 4; ++ks) { fa[ks] = frag_tr(lds + ML_VT, tvo, ks, lane); fb[ks] = frag_row(lds + ML_PM, 32 * ti, ks, lane); }
#pragma unroll
          for (int ks = 0; ks < 4; ++ks) if (ks < 2 || ti == 1) H = MFMA32(fa[ks], fb[ks], H); }
        { float qn = 0.f;
#pragma unroll
          for (int w2 = 0; w2 < 8; ++w2) qn += tqp[w2 * 64 + ii];
          const float den = trs[ii] + trs[64 + ii] + twi[ii] * qn, sc = __builtin_amdgcn_rcpf(fmaxf(fabsf(den), temi[ii]));
#pragma unroll
          for (int r = 0; r < 16; ++r) H[r] *= sc; }
        MSEC(4);
        if (half == 0) {
#pragma unroll
            for (int g = 0; g < 4; ++g) { v2u w; w.x = pk2(H[4 * g], H[4 * g + 1]); w.y = pk2(H[4 * g + 2], H[4 * g + 3]); *(LAS v2u*)(scrA + scr_off(l31, g) + 8 * lh) = w; }
#pragma unroll
            for (int rep = 0; rep < 2; ++rep) { const v4u w = *(const LAS v4u*)(scrA + scr_off((lane >> 2) + 16 * rep, lane & 3));
                bf16* dst = octx ? craw + (size_t)(orow2[rep] - M_LAT) * DM : y + (size_t)orow2[rep] * DM; *(GAS v4u*)(dst + ycol0 + 32 * tvo + 8 * (lane & 3)) = w; }
            LDS_BAR();
        } else {
            float ss = 0.f;
#pragma unroll
            for (int g = 0; g < 4; ++g) { const v2u r2 = *(const LAS v2u*)(scrA + scr_off(l31, g) + 8 * lh); H[4 * g] += bf_lo(r2.x); H[4 * g + 1] += bf_hi(r2.x); H[4 * g + 2] += bf_lo(r2.y); H[4 * g + 3] += bf_hi(r2.y); }
#pragma unroll
            for (int r = 0; r < 16; ++r) ss += H[r] * H[r];
            ss += __shfl_xor(ss, 32);
            const int ii2 = 32 * ti + l31;
            if (lh == 0) ssq[tvo * 64 + ii2] = ss;
            LDS_BAR();
#pragma unroll
            for (int rep = 0; rep < 2; ++rep) *(LAS v4u*)(scrB + scr_off((lane >> 2) + 16 * rep, lane & 3)) = gtv[rep];
            const float tss = (ssq[ii2] + ssq[64 + ii2]) + (ssq[128 + ii2] + ssq[192 + ii2]), rr = __builtin_amdgcn_rsqf(tss * (1.f / 128.f) + RMS_EPS);
            v2u yw[4];
#pragma unroll
            for (int g = 0; g < 4; ++g) { const v2u g2 = *(const LAS v2u*)(scrB + scr_off(l31, g) + 8 * lh); const f32x4 nv = *(const f32x4*)(nwp + 8 * g);
                yw[g].x = pk2(H[4 * g] * rr * nv.x * bf_lo(g2.x), H[4 * g + 1] * rr * nv.y * bf_hi(g2.x)); yw[g].y = pk2(H[4 * g + 2] * rr * nv.z * bf_lo(g2.y), H[4 * g + 3] * rr * nv.w * bf_hi(g2.y)); }
#pragma unroll
            for (int g = 0; g < 4; ++g) *(LAS v2u*)(scrB + scr_off(l31, g) + 8 * lh) = yw[g];
#pragma unroll
            for (int rep = 0; rep < 2; ++rep) { const v4u w = *(const LAS v4u*)(scrB + scr_off((lane >> 2) + 16 * rep, lane & 3)); *(GAS v4u*)(y + (size_t)orow2[rep] * DM + ycol0 + 32 * tvo + 8 * (lane & 3)) = w; }
        }
        if (half == 0 && s == 3 && ctx_out) signal_counter((unsigned*)(F.ws + WS_CTL) + CW_CC, tid == 0);
    }
#ifdef PROBE_MSEC
    if (F.bid == 64 && tid == 0 && l == 0 && half == 0) ((LAS unsigned long long*)(F.lds + LDSCTL_OFF + 2048))[41] = msec_acc;
#endif
#undef MSEC
#undef ML_GATES
#undef ML_LOAD
    if (half == 0) { float* sp = st + ((size_t)wv * 64 + lane) * 16;
        for (int q4 = 0; q4 < 4; ++q4) *(GAS f32x4*)(sp + 4 * q4) = (f32x4){C[4 * q4], C[4 * q4 + 1], C[4 * q4 + 2], C[4 * q4 + 3]};
        __syncthreads();
        if (tid < 64) st[8192 + tid] = tn[tid];
        if (tid == 448) st[8192 + 64] = mprev; }
}

template <int PART>
__device__ __forceinline__ void ctx_pipeline(const Frame& F) {
    unsigned char* ws = F.ws; unsigned* ctl = (unsigned*)(ws + WS_CTL); const bool leader = F.tid == 0; const int sb = F.bid - 128, NS = F.G - 128;
    bf16* const A1c = (bf16*)(ws + WS_A1) + (size_t)M_LAT * DM; bf16* const FC = (bf16*)(ws + WS_FC); bf16* const HC = (bf16*)(ws + WS_HC); bf16* const F2C = (bf16*)(ws + WS_F2C);
    float* const XC = (float*)(ws + WS_XC);
    XcdBarrier sbar; sbar.bar = ctl + CW_BAR2; sbar.x = xb_xcc_id(); sbar.st = (volatile LAS unsigned*)(F.lds + MISC_OFF) + 10; sbar.members = (unsigned)NS;
#define SUB_BAR() xcd_barrier(sbar, leader)
    if (PART == 0) {
        if (leader) (void)xb_add(&sbar.bar[XB_XCNT(sbar.x)], 1u);
        wait_counter(ctl + CW_CC, 128u, leader);
        if (sb < 64) { const int type = sb >> 5, b = (sb >> 2) & 7, h = sb & 3;
            ctx_combine(F, b, type * 512 + h * 128, (type ? F.in(IN_MLNORM) : F.in(IN_HGNORM)) + h * 128, (type ? ZC_MO : ZC_HG) + h * 128); }
        SUB_BAR();
        { pg8::Gemm g{A1c, (const bf16*)(ws + WS_WOUT0), M_CTX, DM, DM}; pg8::StaticOrder S; S.init(M_CTX, DM, NS, sb); pg8::EpiPlain E{FC, DM, 1024};
          pg8::gemm_phase<pg8::EpiPlain, pg8::StaticOrder, true, true>(F.lds, g, S, E, F.tid); }
        SUB_BAR();
        ctx_rows(F, 0, 0, F.in(IN_CTX), FC, XC, A1c, 0, sb, NS);
    } else {
        { pg8::Gemm g{A1c, (const bf16*)(ws + WS_FGU), M_CTX, 2 * DFF, DM}; pg8::StaticOrder S; S.init(M_CTX, 2 * DFF, NS, sb); pg8::EpiSwiGLU E{HC, DFF, 1024, 0};
          pg8::gemm_phase<pg8::EpiSwiGLU, pg8::StaticOrder, true, true>(F.lds, g, S, E, F.tid); }
        SUB_BAR();
        { pg8::Gemm g{HC, (const bf16*)(ws + WS_FDN), M_CTX, DM, DFF}; pg8::StaticOrder S; S.init(M_CTX, DM, NS, sb); pg8::EpiPlain E{F2C, DM, 1024};
          pg8::gemm_phase<pg8::EpiPlain, pg8::StaticOrder, true, true>(F.lds, g, S, E, F.tid); }
        SUB_BAR();
        ctx_rows(F, 0, 1, XC, F2C, XC, A1c, 1, sb, NS);
        SUB_BAR();
        { gates_mfma(F, 1, 128, NS, M_LAT / 16, M_ALL / 16);
          pg8::Gemm g{A1c, (const bf16*)(ws + WS_WIN1), M_CTX, ZLD, DM}; pg8::StaticOrder S; S.init(M_CTX, ZLD, NS, sb); pg8::EpiZ E{(bf16*)(ws + WS_Z) + (size_t)M_LAT * ZLD, (const float*)(ws + WS_LBV) + 1024};
          pg8::gemm_phase<pg8::EpiZ, pg8::StaticOrder, true, true>(F.lds, g, S, E, F.tid); }
    }
#undef SUB_BAR
}
#ifndef EN_MASK
#define EN_MASK 0xffff
#endif
#define EN(c) (((EN_MASK) >> (c)) & 1)
__global__ void __launch_bounds__(NTHREADS, 2) hyb_fwd(Args args) {
    extern __shared__ __attribute__((aligned(16))) unsigned char lds_raw[];
    Frame F0;
    F0.lds = (LAS unsigned char*)lds_raw;
    F0.tid = threadIdx.x; F0.lane = F0.tid & 63; F0.wave = __builtin_amdgcn_readfirstlane(F0.tid >> 6);
    F0.bid = blockIdx.x; F0.G = gridDim.x; F0.ws = args.ws;
    volatile LAS unsigned* MISC = (volatile LAS unsigned*)(F0.lds + MISC_OFF);
    for (int u = F0.tid; u < (LDS_BYTES - LDSCTL_OFF) / 4; u += NTHREADS) ((LAS unsigned*)(F0.lds + LDSCTL_OFF))[u] = 0u;
    if (F0.tid == 0) { LAS unsigned long long* tab = (LAS unsigned long long*)(F0.lds + PTAB_OFF);
#pragma unroll
        for (int i = 0; i < 22; ++i) tab[i] = (unsigned long long)args.in[i];
        tab[22] = (unsigned long long)args.out; }
    __syncthreads();
    const bool single = args.single != 0;
    XcdBarrier bar; bar.bar = (unsigned*)(args.ws + WS_CTL) + CW_BAR; bar.x = 0; bar.st = nullptr; bar.members = 0u;
    if (single) bar = xcd_barrier_post((unsigned*)(args.ws + WS_CTL) + CW_BAR, MISC + 8, F0.tid == 0);
#define CODE_() ({ int c_ = args.code; asm volatile("" : "+s"(c_)); c_; })
#define RUN(c, l) (single || (CODE_() == (c) && args.layer == (l)))
#ifndef SKIP_H
#define SKIP_H 0
#endif
#ifndef SKIP_M
#define SKIP_M 0
#endif
#ifndef PROBE_SCALE
#define PROBE_SCALE 0.05f
#endif
#ifdef PROBE_STAMPS
    LAS unsigned long long* const tsl = (LAS unsigned long long*)(F0.lds + LDSCTL_OFF + 2048); int nst = 0;
#define STAMP() do { if (blockIdx.x == 0 && F0.wave == 0 && __lane_id() == 0) tsl[nst] = __builtin_amdgcn_s_memrealtime(); ++nst; } while (0)
#else
#define STAMP() do {} while (0)
#endif
    STAMP();
#define LEADER_() (F0.wave == 0 && __lane_id() == 0)
#define GRID_BAR() do { if (single) { unsigned long long bp_ = (unsigned long long)args.ws; asm volatile("" : "+s"(bp_)); XcdBarrier b_ = bar; b_.bar = (unsigned*)(bp_ + WS_CTL) + CW_BAR;     \
        xcd_barrier(b_, LEADER_()); } STAMP(); } while (0)

#define PHASE_LOCALS const Frame F = phase_frame(F0); unsigned char* const ws = F.ws; bf16* const A1 = (bf16*)(ws + WS_A1); bf16* const Z = (bf16*)(ws + WS_Z); float* const XC = (float*)(ws + WS_XC); \
    const float* const x_in = F.in(IN_X); const float* const ctx_in = F.in(IN_CTX); float* const outp = (float*)F.in(22); (void)A1; (void)Z; (void)XC; (void)x_in; (void)ctx_in; (void)outp;

    if (EN(PH_P0) && RUN(PH_P0, 0)) { PHASE_LOCALS phase_p0(F); GRID_BAR(); }
#ifdef PROBE_EXTRA_BAR
    GRID_BAR(); GRID_BAR();
#endif
    if (EN(PH_P1) && RUN(PH_P1, 0)) { PHASE_LOCALS row_phase<false, false, false, true, 0>(F, 0, 1, x_in, ctx_in, A1, outp, XC, A1, 0, true); convert_layer0_weights(F); GRID_BAR(); }

#pragma unroll 1
    for (int l = 0; l < DEPTH; ++l) {
        const bool last = (l == DEPTH - 1);
        if (EN(PH_INPROJ) && RUN(PH_INPROJ, l)) { PHASE_LOCALS
            const int kk = IP_K(l), Mi = 8 * 2 * kk * 256 + (l ? 0 : M_CTX);
            pg8::Gemm g{A1, (const bf16*)(ws + (l ? WS_WIN1 : WS_WIN0)), Mi, ZLD, DM}; pg8::SubsetOrder S; S.init(Mi, ZLD, F.G, F.bid); S.k = kk; S.inner = 0;
            pg8::EpiZ E{Z, (const float*)(ws + WS_LBV) + l * 1024};
            pg8::gemm_phase<pg8::EpiZ, pg8::SubsetOrder, true, true>(F.lds, g, S, E, F.tid);
            if (l == 0) { if (F.bid >= 128) gates_mfma(F, l, 128, F.G - 128, 0, M_ALL / 16); }
            else gates_mfma(F, l, 0, F.G, 0, M_LAT / 16);
            GRID_BAR();
        }
        if (EN(PH_SCAN_A) && RUN(PH_SCAN_A, l)) { PHASE_LOCALS
            if (F.bid < 128) { const int b = (F.bid >> 3) & 7, h = (F.bid >> 1) & 3, dir = F.bid & 1;
                if (F.bid < 64) { if (!SKIP_H) hgrn_scan(F, l, b, h, dir, 0, !last); } else { if (!SKIP_M) mlstm_scan(F, l, b, h, dir, 0, !last); } }
            else { const int kk = IP_K(l), Mi = 8 * (16 - 2 * kk) * 256;
                pg8::Gemm g{A1, (const bf16*)(ws + (l ? WS_WIN1 : WS_WIN0)), Mi, ZLD, DM}; pg8::SubsetOrder S; S.init(Mi, ZLD, F.G - 128, F.bid - 128); S.k = kk; S.inner = 1;
                pg8::EpiZ E{Z, (const float*)(ws + WS_LBV) + l * 1024};
                pg8::gemm_phase<pg8::EpiZ, pg8::SubsetOrder, true, true>(F.lds, g, S, E, F.tid);
                signal_counter((unsigned*)(ws + WS_CTL) + CW_IP2 + 64 * l, LEADER_()); }
            if (F.bid < 128) {}
            else if (l == 0) { convert_layer1_weights(F, 128, F.G - 128, T_WIN + T_WOUT, T_L1A); ctx_pipeline<0>(F); }
            else convert_layer1_weights(F, 128, F.G - 128, T_L1A, T_L1A + (T_TOTAL - T_L1A) / 2);
            GRID_BAR();
        }
        if (EN(PH_SCAN_B) && RUN(PH_SCAN_B, l)) { PHASE_LOCALS
            if (F.bid < 128) { const int b = (F.bid >> 3) & 7, h = (F.bid >> 1) & 3, dir = F.bid & 1;
                if (F.bid < 64) { if (!SKIP_H) hgrn_scan(F, l, b, h, dir, 1, !last); } else { if (!SKIP_M) mlstm_scan(F, l, b, h, dir, 1, !last); } }
            else if (l != 0) convert_layer1_weights(F, 128, F.G - 128, T_L1A + (T_TOTAL - T_L1A) / 2, T_TOTAL);
            else ctx_pipeline<1>(F);
            GRID_BAR();
        }
        if (EN(PH_OUTPROJ) && RUN(PH_OUTPROJ, l)) { PHASE_LOCALS
            const int M = M_LAT;
            pg8::Gemm g{A1, (const bf16*)(ws + (l ? WS_WOUT1 : WS_WOUT0)), M, DM, DM}; pg8::StaticOrder S; S.init(M, DM, F.G, F.bid);
            pg8::EpiPlain E{Z, DM, 1024};
            pg8::gemm_phase<pg8::EpiPlain, pg8::StaticOrder, true, true>(F.lds, g, S, E, F.tid);
            GRID_BAR();
        }
        if (EN(PH_RESLN1) && RUN(PH_RESLN1, l)) { PHASE_LOCALS
            if (l == 0) row_phase<true, true, true, true, 0, false, true>(F, l, 0, x_in, ctx_in, Z, outp, XC, A1, l, false);
            else        row_phase<true, true, true, true, 1, true, true>(F, l, 0, outp, XC, Z, outp, XC, A1, l, false);
            GRID_BAR();
        }
        const bool moe = (l & 1) != 0;
        if (EN(PH_FFNUP) && !moe && RUN(PH_FFNUP, l)) { PHASE_LOCALS
            pg8::Gemm g{A1, (const bf16*)(ws + WS_FGU), M_LAT, 2 * DFF, DM}; pg8::StaticOrder S; S.init(M_LAT, 2 * DFF, F.G, F.bid);
            pg8::EpiSwiGLU E{Z, DFF, 1024, 1};
            pg8::gemm_phase<pg8::EpiSwiGLU, pg8::StaticOrder, true, true>(F.lds, g, S, E, F.tid);
            GRID_BAR();
        }
        if (EN(PH_FFNDN) && !moe && RUN(PH_FFNDN, l)) { PHASE_LOCALS
            pg8::Gemm g{Z, (const bf16*)(ws + WS_FDN), M_LAT, DM, DFF}; pg8::StaticOrder S; S.init(M_LAT, DM, F.G, F.bid);
            pg8::EpiPlain E{(bf16*)(ws + WS_Z + ZOFF_F2), DM, 1024};
            pg8::gemm_phase<pg8::EpiPlain, pg8::StaticOrder, true, true, false, true>(F.lds, g, S, E, F.tid);
            GRID_BAR();
        }
        if (EN(PH_RESLN2) && !moe && RUN(PH_RESLN2, l)) { PHASE_LOCALS
            row_phase<true, true, true, true, 0, true, true>(F, l, 1, outp, XC, (const bf16*)(ws + WS_Z + ZOFF_F2), outp, XC, A1, l + 1, false);
            GRID_BAR();
        }
        if (EN(PH_MOEACC) && moe && RUN(PH_MOEACC, l)) { PHASE_LOCALS
            phase_moe_dispatch(F);
            GRID_BAR();
        }
        if (EN(PH_MOEUP) && moe && RUN(PH_MOEUP, l)) { PHASE_LOCALS
            pg8::Gemm g{A1, (const bf16*)(ws + WS_MGU), 0, 2 * DEXP, DM}; pg8::MoeUpOrder S; S.init((const int*)(ws + WS_META), 11, F.G, F.bid);
            S.rfull = (unsigned*)(ws + WS_CTL) + CW_MFULL; S.rtail = (unsigned*)(ws + WS_CTL) + CW_MTAIL; S.wv = F.wave; S.nd = 0;
            pg8::EpiSwiGLU E{Z, DEXP, 11, 1};
            pg8::gemm_phase<pg8::EpiSwiGLU, pg8::MoeUpOrder, true, true, true>(F.lds, g, S, E, F.tid, (const int*)(ws + WS_SLOTTOK));
        }
        if (EN(PH_MOEDN) && moe && RUN(PH_MOEDN, l)) { PHASE_LOCALS
            wait_counter((unsigned*)(ws + WS_CTL) + CW_MFULL, (unsigned)F.G, LEADER_());
            const int nwu = __builtin_amdgcn_readfirstlane(((const int*)(ws + WS_META))[8]) * 11, ntail = nwu - (nwu / F.G) * F.G;
            pg8::Gemm g{Z, (const bf16*)(ws + WS_MDN), 0, DM, DEXP}; pg8::MoeDnOrder S; S.init((const int*)(ws + WS_META), 4, F.G, (F.bid + F.G - ntail) % F.G);
            S.rtail = (const unsigned*)(ws + WS_CTL) + CW_MTAIL; S.ntail = (unsigned)ntail; S.nwg_up = nwu; S.wv = F.wave; S.na = 0; S.got = (ntail == 0) ? 1 : 0;
            S.dfull = (unsigned*)(ws + WS_CTL) + CW_DFULL; S.dtail = (unsigned*)(ws + WS_CTL) + CW_DTAIL; S.nd = 0;
            pg8::EpiPlain E{(bf16*)(ws + WS_Z + ZOFF_OPERM), DM, 4};
            pg8::gemm_phase<pg8::EpiPlain, pg8::MoeDnOrder, true, true, false, true>(F.lds, g, S, E, F.tid);
        }
        if (EN(PH_FINAL) && moe && RUN(PH_FINAL, l)) { PHASE_LOCALS
            final_phase(F, l, outp, (const bf16*)(ws + WS_Z + ZOFF_OPERM), outp, LEADER_());
        }
    }
#ifdef PROBE_STAMPS
    STAMP();
    __syncthreads();
    if (blockIdx.x == 0) { float* o = args.out;
#ifdef PROBE_SEC
        const float A = (float)tsl[40] * (1.0f / 36.0f) * 0.01f;
#else
        const float A = (float)(tsl[PROBE_A1] - tsl[PROBE_A0]) * 0.01f;
#endif
        VM_WAIT(); __syncthreads();
        if (threadIdx.x == 0) o[0] = o[0] + PROBE_SCALE * A; }
#endif
#ifdef PROBE_MSEC
    __syncthreads();
    if (blockIdx.x == 64) { float* o = args.out + (size_t)64 * 128 * DM; const float A = (float)tsl[41] * (1.0f / 36.0f) * 0.01f;
        VM_WAIT(); __syncthreads();
        if (threadIdx.x == 0) o[0] = o[0] + PROBE_SCALE * A; }
#endif
#undef RUN
#undef GRID_BAR
}

extern "C" void kernel_launch(void* const* d_in, const int* in_sizes, int n_in, void* d_out, int out_size, void* d_ws, size_t ws_size, hipStream_t stream) {
    static int grid = 0;
    if (grid == 0) {
        if (n_in != 22 || out_size != M_LAT * DM || ws_size < WS_END) { fprintf(stderr, "kernel_launch: unexpected shapes (n_in %d, out %d, ws %zu)\n", n_in, out_size, ws_size); grid = -1; return; }
        int dev = 0, cus = 0, per_cu = 0;
        if (hipGetDevice(&dev) != hipSuccess || hipDeviceGetAttribute(&cus, hipDeviceAttributeMultiprocessorCount, dev) != hipSuccess) { grid = -1; return; }
        if (hipFuncSetAttribute((const void*)hyb_fwd, hipFuncAttributeMaxDynamicSharedMemorySize, LDS_BYTES) != hipSuccess) { fprintf(stderr, "kernel_launch: hipFuncSetAttribute failed\n"); grid = -1; return; }
        if (hipOccupancyMaxActiveBlocksPerMultiprocessor(&per_cu, (const void*)hyb_fwd, NTHREADS, LDS_BYTES) != hipSuccess || per_cu < 1) fprintf(stderr, "kernel_launch: occupancy query reports %d\n", per_cu);
        (void)hipGetLastError();
        grid = cus;
        if (grid != 256) fprintf(stderr, "kernel_launch: %d CUs (built for 256)\n", grid);
    }
    if (grid < 0) return;
    (void)hipMemsetAsync((char*)d_ws + WS_CTL, 0, CTL_ZERO_BYTES, stream);
    Args a{};
    for (int i = 0; i < 22; ++i) a.in[i] = (const float*)d_in[i];
    a.out = (float*)d_out; a.ws = (unsigned char*)d_ws; a.single = 0; a.expert = 0;
#ifndef MAX_LAUNCHES
#define MAX_LAUNCHES 1000
#endif
    int nl = 0;
    auto launch = [&](int code, int layer, int expert) { if (nl++ >= MAX_LAUNCHES) return; a.code = code; a.layer = layer; a.expert = expert; hipLaunchKernelGGL(hyb_fwd, dim3(grid), dim3(NTHREADS), LDS_BYTES, stream, a); };
#ifndef MULTI_LAUNCH
    a.single = 1; a.code = 0; a.layer = 0; a.expert = 0;
    hipLaunchKernelGGL(hyb_fwd, dim3(grid), dim3(NTHREADS), LDS_BYTES, stream, a);
    return;
#endif
    launch(PH_P0, 0, 0); launch(PH_P1, 0, 0);
    launch(PH_INPROJ, 0, 0); launch(PH_SCAN_A, 0, 0); launch(PH_SCAN_B, 0, 0); launch(PH_OUTPROJ, 0, 0); launch(PH_RESLN1, 0, 0); launch(PH_FFNUP, 0, 0); launch(PH_FFNDN, 0, 0); launch(PH_RESLN2, 0, 0);
    launch(PH_INPROJ, 1, 0); launch(PH_SCAN_A, 1, 0); launch(PH_SCAN_B, 1, 0); launch(PH_OUTPROJ, 1, 0); launch(PH_RESLN1, 1, 0);
    launch(PH_MOEACC, 1, 0); launch(PH_MOEUP, 1, 0); launch(PH_MOEDN, 1, 0);
    launch(PH_FINAL, 1, 0);
}
```

```cpp
#include <hip/hip_runtime.h>
#include <cstdio>
#include <cstdint>

constexpr int DM = 1024, NBATCH = 8, SEQ = 4096, CTXL = 256, DEPTH = 2;
constexpr int M_LAT = NBATCH * SEQ;
constexpr int M_CTX = NBATCH * CTXL;
constexpr int M_ALL = M_LAT + M_CTX;
constexpr int PROJ = 4112;
constexpr int ZLD = 4096;
constexpr int ZC_HQ = 0, ZC_HF0 = 512, ZC_HF1 = 1024, ZC_HI = 1536, ZC_HG = 2048, ZC_MQ = 2560, ZC_MK = 2816, ZC_MV = 3072, ZC_MO = 3584;
constexpr int DFF = 2816, NEXP = 8, DEXP = 1408;
constexpr float LN_EPS = 1e-5f, RMS_EPS = 1e-6f;
constexpr float DN_ALPHA = 1.41421356237309515f;
constexpr int NWAVES = 8, NTHREADS = 512;

#ifndef IP_K0
#define IP_K0 7
#endif
#ifndef IP_K1
#define IP_K1 6
#endif
#define IP_K(l_) ((l_) ? IP_K1 : IP_K0)
namespace pg8 {
#define PG8_LAS __attribute__((address_space(3)))
typedef unsigned short bf16_t;
typedef short bf16x8 __attribute__((ext_vector_type(8)));
typedef float f32x4 __attribute__((ext_vector_type(4)));
typedef unsigned u32x4 __attribute__((ext_vector_type(4)));
constexpr int BM = 256, BK = 64, HALF = 128, HTB = HALF * BK * 2  , STAGE_BYTES = 8 * HTB, NXCD = 8, WGM = 8;

__host__ __device__ __forceinline__ int lds_byte(int r, int c) { const int st = (r >> 4) * 2 + (c >> 5), rr = r & 15, cc = c & 31, ob = rr * 64 + cc * 2; return st * 1024 + (ob ^ (((ob >> 9) & 1) << 5)); }
__host__ __device__ __forceinline__ void stage_rc(int b, int& R, int& C) { const int st = b / 1024, sb = b % 1024, swz = sb ^ (((sb >> 9) & 1) << 5); R = (st >> 1) * 16 + swz / 64; C = (st & 1) * 32 + (swz % 64) / 2; }
__host__ __device__ __forceinline__ int perm32(int rho) { const int n = rho >> 4, i = rho & 15; return 8 * (i >> 2) + 4 * n + (i & 3); }

struct Unit { int pm, pn; };
struct Gemm { const bf16_t* A; const bf16_t* Bt; int M, N, K; int ld; };

struct StaticOrder {
    int nM, nN, nwg, G, c;
    __host__ __device__ void init(int M, int N, int G_, int c_) { nM = M / BM; nN = N / BM; nwg = nM * nN; G = G_; c = c_; }
    __host__ __device__ bool next(int i, Unit& u) const {
        const long L = (long)i * G + c; if (L >= nwg) return false;
        int wgid = (int)L; { const int q = nwg / NXCD, r = nwg % NXCD, xcd = wgid % NXCD, off = wgid / NXCD; wgid = (xcd < r ? xcd * (q + 1) : r * (q + 1) + (xcd - r) * q) + off; }
        const int nig = WGM * nN, gid = wgid / nig, fm = gid * WGM, gsz = (nM - fm) < WGM ? (nM - fm) : WGM;
        u.pm = fm + ((wgid % nig) % gsz); u.pn = (wgid % nig) / gsz; return true;
    }
    __device__ __forceinline__ void a_ready(const Unit&) const {}
    __device__ __forceinline__ void done(const Unit&) const {}
};
typedef __bf16 bf16x2_nat __attribute__((ext_vector_type(2)));
typedef float f32x2_nat __attribute__((ext_vector_type(2)));
__device__ __forceinline__ unsigned cvt_pk_bf16(float lo, float hi) { const f32x2_nat v = {lo, hi}; const bf16x2_nat r = __builtin_convertvector(v, bf16x2_nat); return __builtin_bit_cast(unsigned, r); }
__device__ __forceinline__ float fsigmoid(float x) { return __builtin_amdgcn_rcpf(1.0f + __expf(-x)); }
__device__ __forceinline__ float fsilu(float x) { return x * fsigmoid(x); }
__device__ __forceinline__ f32x4 silu4(f32x4 v) { return (f32x4){fsilu(v[0]), fsilu(v[1]), fsilu(v[2]), fsilu(v[3])}; }
__device__ __forceinline__ f32x4 sigm4(f32x4 v) { return (f32x4){fsigmoid(v[0]), fsigmoid(v[1]), fsigmoid(v[2]), fsigmoid(v[3])}; }
__device__ __forceinline__ float flogf1(float z, float lb) { z = fminf(fmaxf(z, -30.f), 30.f); const float s = fsigmoid(z); return __log2f(lb + (1.0f - lb) * s); }
__device__ __forceinline__ f32x4 logf4(f32x4 v, f32x4 lb) { return (f32x4){flogf1(v[0], lb[0]), flogf1(v[1], lb[1]), flogf1(v[2], lb[2]), flogf1(v[3], lb[3])}; }
__device__ __forceinline__ u32x4 pack8(f32x4 v0, f32x4 v1) { u32x4 w; w.x = cvt_pk_bf16(v0[0], v0[1]); w.y = cvt_pk_bf16(v0[2], v0[3]); w.z = cvt_pk_bf16(v1[0], v1[1]); w.w = cvt_pk_bf16(v1[2], v1[3]); return w; }

struct EpiZ {
    static constexpr bool PERM = true, AFTER_DRAIN = false;
    bf16_t* O; const float* lbv;
    __device__ __forceinline__ void operator()(const f32x4 (&acc)[2][2][4][2], const Unit& u, int wr, int wc, int fr, int fq) const {
        const int row0 = u.pm * BM + wr * 64 + fr, col0 = u.pn * BM + wc * 32 + 8 * fq;
        const int grp = u.pn >> 1;
#ifdef PROBE_EPIZ_PLAIN
        const int mode = 0; (void)grp;
#else
        const int mode = (grp == 0 || grp == 4) ? 1 : ((grp == 1 || grp == 2) ? 2 : (grp == 7 ? 3 : 0));
#endif
        if (mode == 2) {
            f32x4 lb[2][2];
#pragma unroll
            for (int bj = 0; bj < 2; ++bj)
#pragma unroll
                for (int n = 0; n < 2; ++n) lb[bj][n] = *(const f32x4*)(lbv + (col0 - 512) + bj * HALF + 4 * n);
#pragma unroll
            for (int ai = 0; ai < 2; ++ai)
#pragma unroll
                for (int m = 0; m < 4; ++m) { bf16_t* rowp = O + (size_t)(row0 + ai * HALF + m * 16) * 4096 + col0;
#pragma unroll
                    for (int bj = 0; bj < 2; ++bj) *(u32x4*)(rowp + bj * HALF) = pack8(logf4(acc[ai][bj][m][0], lb[bj][0]), logf4(acc[ai][bj][m][1], lb[bj][1])); }
        } else if (mode == 1) {
#pragma unroll
            for (int ai = 0; ai < 2; ++ai)
#pragma unroll
                for (int m = 0; m < 4; ++m) { bf16_t* rowp = O + (size_t)(row0 + ai * HALF + m * 16) * 4096 + col0;
#pragma unroll
                    for (int bj = 0; bj < 2; ++bj) *(u32x4*)(rowp + bj * HALF) = pack8(silu4(acc[ai][bj][m][0]), silu4(acc[ai][bj][m][1])); }
        } else if (mode == 3) {
#pragma unroll
            for (int ai = 0; ai < 2; ++ai)
#pragma unroll
                for (int m = 0; m < 4; ++m) { bf16_t* rowp = O + (size_t)(row0 + ai * HALF + m * 16) * 4096 + col0;
#pragma unroll
                    for (int bj = 0; bj < 2; ++bj) *(u32x4*)(rowp + bj * HALF) = pack8(sigm4(acc[ai][bj][m][0]), sigm4(acc[ai][bj][m][1])); }
        } else {
#pragma unroll
            for (int ai = 0; ai < 2; ++ai)
#pragma unroll
                for (int m = 0; m < 4; ++m) { bf16_t* rowp = O + (size_t)(row0 + ai * HALF + m * 16) * 4096 + col0;
#pragma unroll
                    for (int bj = 0; bj < 2; ++bj) *(u32x4*)(rowp + bj * HALF) = pack8(acc[ai][bj][m][0], acc[ai][bj][m][1]); }
        }
    }
};
struct EpiPlain {
    static constexpr bool PERM = true, AFTER_DRAIN = false;
    bf16_t* O; int ldc; int pn_mod;
    __device__ __forceinline__ void operator()(const f32x4 (&acc)[2][2][4][2], const Unit& u, int wr, int wc, int fr, int fq) const {
        const int row0 = u.pm * BM + wr * 64 + fr, col0 = (u.pn % pn_mod) * BM + wc * 32 + 8 * fq;
#pragma unroll
        for (int ai = 0; ai < 2; ++ai)
#pragma unroll
            for (int m = 0; m < 4; ++m) { bf16_t* rowp = O + (size_t)(row0 + ai * HALF + m * 16) * ldc + col0;
#pragma unroll
                for (int bj = 0; bj < 2; ++bj) *(u32x4*)(rowp + bj * HALF) = pack8(acc[ai][bj][m][0], acc[ai][bj][m][1]); }
    }
};
struct EpiSwiGLU {
    static constexpr bool PERM = true, AFTER_DRAIN = false;
    bf16_t* H; int ldh; int pn_mod; int blk;
    __device__ __forceinline__ void operator()(const f32x4 (&acc)[2][2][4][2], const Unit& u, int wr, int wc, int fr, int fq) const {
        const int col0 = (u.pn % pn_mod) * HALF + wc * 32 + 8 * fq;
        const int rs = blk ? BK : ldh;
        bf16_t* base = blk ? H + ((size_t)(u.pm * (ldh / BK) + (col0 >> 6)) * BM + wr * 64 + fr) * BK + (col0 & 63) : H + (size_t)(u.pm * BM + wr * 64 + fr) * ldh + col0;
#pragma unroll
        for (int ai = 0; ai < 2; ++ai)
#pragma unroll
            for (int m = 0; m < 4; ++m) { bf16_t* rowp = base + (size_t)(ai * HALF + m * 16) * rs;
                *(u32x4*)rowp = pack8(silu4(acc[ai][0][m][0]) * acc[ai][1][m][0], silu4(acc[ai][0][m][1]) * acc[ai][1][m][1]); }
    }
};

struct MoeOrder {
    int npn, nwg, G, c; int ps[7];
    __device__ __forceinline__ void init(const int* meta, int npn_, int G_, int c_) { npn = npn_; G = G_; c = c_;
#pragma unroll
        for (int k = 0; k < 7; ++k) ps[k] = __builtin_amdgcn_readfirstlane(meta[k + 1]);
        nwg = __builtin_amdgcn_readfirstlane(meta[8]) * npn_; }
    __device__ __forceinline__ bool next(int i, Unit& u) const {
        const long L = (long)i * G + c; if (L >= nwg) return false;
        int wgid = (int)L; { const int q = nwg / NXCD, r = nwg % NXCD, xcd = wgid % NXCD, off = wgid / NXCD; wgid = (xcd < r ? xcd * (q + 1) : r * (q + 1) + (xcd - r) * q) + off; }
        const int pm = wgid / npn, pl = wgid - pm * npn; int ex = 0;
#pragma unroll
        for (int k = 0; k < 7; ++k) ex += (pm >= ps[k]) ? 1 : 0;
        u.pm = pm; u.pn = ex * npn + pl; return true;
    }
    __device__ __forceinline__ void a_ready(const Unit&) const {}
    __device__ __forceinline__ void done(const Unit&) const {}
};

struct MoeUpOrder : MoeOrder {
    unsigned* rfull; unsigned* rtail; int wv; mutable int nd;
    __device__ __forceinline__ void done(const Unit&) const {
        const int fr = nwg / G; ++nd;
        if (nd == fr || nd == fr + 1) {
            asm volatile("s_waitcnt vmcnt(0)" ::: "memory"); __builtin_amdgcn_s_barrier(); asm volatile("" ::: "memory");
            if (wv == 0 && __lane_id() == 0) { __builtin_amdgcn_fence(__ATOMIC_RELEASE, "agent"); asm volatile("s_waitcnt vmcnt(0)" ::: "memory");
                __hip_atomic_fetch_add(nd == fr ? rfull : rtail, 1u, __ATOMIC_RELAXED, __HIP_MEMORY_SCOPE_AGENT); } }
    }
};
struct MoeDnOrder : MoeOrder {
    const unsigned* rtail; unsigned ntail; int nwg_up, wv; mutable int na, got;
    __device__ __forceinline__ bool tail_panel(int pm) const {
        const int a = 11 * pm, b = a + 11, q = nwg_up / NXCD, r = nwg_up % NXCD, thr = (nwg_up / G) * (G / NXCD); int st = 0; bool any = false;
#pragma unroll
        for (int x = 0; x < NXCD; ++x) { const int sz = q + (x < r ? 1 : 0), lo = st + thr, hi = st + sz; any = any || ((a > lo ? a : lo) < (b < hi ? b : hi)); st += sz; }
        return any;
    }
    __device__ __forceinline__ void a_ready(const Unit& u) const {
        const int i = na; ++na;
        if (got || (i == 0 && !tail_panel(u.pm))) return;
        if (wv == 0) { unsigned sp = 0;
            while ((unsigned)__builtin_amdgcn_readfirstlane(__hip_atomic_load(rtail, __ATOMIC_RELAXED, __HIP_MEMORY_SCOPE_AGENT)) < ntail) { __builtin_amdgcn_s_sleep(1); if (++sp > (1u << 22)) break; }
            __builtin_amdgcn_fence(__ATOMIC_ACQUIRE, "agent"); asm volatile("s_waitcnt vmcnt(0)" ::: "memory"); }
        asm volatile("" ::: "memory"); __builtin_amdgcn_s_barrier(); asm volatile("" ::: "memory");
        got = 1;
    }
};

struct SubsetOrder : StaticOrder {
    int k, inner;
    __device__ __forceinline__ bool next(int i, Unit& u) const {
        if (!StaticOrder::next(i, u)) return false;
        const int p = u.pm;
        if (inner) { const int per = 16 - 2 * k; u.pm = 16 * (p / per) + k + p % per; }
        else { const int per = 2 * k; if (p >= 8 * per) u.pm = 128 + (p - 8 * per); else { const int j = p % per; u.pm = 16 * (p / per) + (j < k ? j : j + 16 - per); } }
        u.pn = 2 * ((0x65734201u >> (4 * (u.pn >> 1))) & 7u) + (u.pn & 1);
        return true;
    }
};
template <class Epi, class Sched, bool ALIGN_EPI = false, bool SP2 = false, bool GATHER = false, bool ABLK = false>
__device__ __forceinline__ void gemm_phase(PG8_LAS unsigned char* lds, const Gemm g, const Sched& S, const Epi& E, int tid_in, const int* gtab = nullptr) {
    int tid_ = tid_in; asm volatile("" : "+v"(tid_));
    const int tid = tid_, wid = __builtin_amdgcn_readfirstlane(tid >> 6), lane = tid & 63, wr = wid >> 2, wc = wid & 3, fr = lane & 15, fq = lane >> 4;
    const int K = g.K, nt = K / BK, LD = g.ld ? g.ld : g.K, LDA = ABLK ? BK : LD;
    unsigned voffA[2], voffB[2]; int rA[2]; unsigned cA2[2];
#pragma unroll
    for (int i = 0; i < 2; ++i) { int R, C; stage_rc(tid * 16 + i * 8192, R, C); const int Rb = Epi::PERM ? ((R & ~31) + perm32(R & 31)) : R;
        voffA[i] = (unsigned)(R * LDA + C) * 2u; voffB[i] = (unsigned)(Rb * LD + C) * 2u; rA[i] = R; cA2[i] = (unsigned)C * 2u; }
    const size_t kstep = (size_t)(BK * 2);
    const size_t hstep = (size_t)HALF * LD * 2;
    const size_t tstep = 2 * hstep;
    const size_t kstepA = ABLK ? (size_t)(256 * BK * 2) : kstep, hstepA = ABLK ? (size_t)(HALF * BK * 2) : hstep, tstepA = ABLK ? (size_t)nt * (256 * BK * 2) : tstep;
    const unsigned ldsw = (unsigned)wid * 1024u;
    const int aoff = lds_byte(wr * 64 + fr, fq * 8), boff = lds_byte(wc * 32 + fr, fq * 8);
#define PG8_SA(b, h) (((b) * 2 + (h)) * HTB)
#define PG8_SB(b, h) ((4 + (b) * 2 + (h)) * HTB)
#define PG8_STAGE(bufoff, gbase, voff) do { _Pragma("unroll") for (int _i = 0; _i < 2; ++_i) \
        __builtin_amdgcn_global_load_lds((const unsigned*)((const char*)(gbase) + (voff)[_i]), (PG8_LAS unsigned*)(lds + (bufoff) + ldsw + _i * 8192), 16, 0, 0); } while (0)
#define PG8_LDA(dst, b, h) do { _Pragma("unroll") for (int m = 0; m < 4; ++m) _Pragma("unroll") for (int k = 0; k < 2; ++k) dst[m][k] = *(const PG8_LAS bf16x8*)(lds + PG8_SA(b, h) + aoff + m * 2048 + k * 1024); } while (0)
#define PG8_LDB(dst, b, h) do { _Pragma("unroll") for (int n = 0; n < 2; ++n) _Pragma("unroll") for (int k = 0; k < 2; ++k) dst[n][k] = *(const PG8_LAS bf16x8*)(lds + PG8_SB(b, h) + boff + n * 2048 + k * 1024); } while (0)
#define PG8_MMA(ai, bj, At, Bt) do { __builtin_amdgcn_s_setprio(1); _Pragma("unroll") for (int m = 0; m < 4; ++m) _Pragma("unroll") for (int n = 0; n < 2; ++n) _Pragma("unroll") for (int k = 0; k < 2; ++k) \
        acc[ai][bj][m][n] = __builtin_amdgcn_mfma_f32_16x16x32_bf16(Bt[n][k], At[m][k], acc[ai][bj][m][n], 0, 0, 0); __builtin_amdgcn_s_setprio(0); } while (0)
#define PG8_WAIT_V(n) asm volatile("s_waitcnt vmcnt(" #n ")" ::: "memory")
#define PG8_WAIT_L(n) asm volatile("s_waitcnt lgkmcnt(" #n ")" ::: "memory")
#define PG8_BAR __builtin_amdgcn_s_barrier()
#define PG8_SCHED __builtin_amdgcn_sched_barrier(0)
    Unit cur, nxt; int ui = 0;
    if (!S.next(0, cur)) return;
    f32x4 acc[2][2][4][2];
#pragma unroll
    for (int a = 0; a < 2; ++a)
#pragma unroll
        for (int b = 0; b < 2; ++b)
#pragma unroll
            for (int m = 0; m < 4; ++m)
#pragma unroll
                for (int n = 0; n < 2; ++n) acc[a][b][m][n] = (f32x4){0.f, 0.f, 0.f, 0.f};
    bf16x8 At[4][2], B0[2][2], B1[2][2];
    const char* cA = GATHER ? (const char*)g.A : (const char*)g.A + (size_t)cur.pm * tstepA; const char* cB = (const char*)g.Bt + (size_t)cur.pn * tstep;
    unsigned cva0[2], cva1[2], nva0[2], nva1[2];
#pragma unroll
    for (int i = 0; i < 2; ++i) {
        if constexpr (GATHER) { cva0[i] = ((unsigned)gtab[cur.pm * 256 + rA[i]] * (unsigned)LD) * 2u + cA2[i]; cva1[i] = ((unsigned)gtab[cur.pm * 256 + 128 + rA[i]] * (unsigned)LD) * 2u + cA2[i]; }
        else { cva0[i] = voffA[i]; cva1[i] = voffA[i] + (unsigned)hstepA; }
        nva0[i] = cva0[i]; nva1[i] = cva1[i]; }
    S.a_ready(cur);
    if constexpr (SP2) {
        PG8_STAGE(PG8_SB(0, 0), cB, voffB); PG8_STAGE(PG8_SB(0, 1), cB + hstep, voffB); PG8_STAGE(PG8_SA(0, 0), cA, cva0); PG8_STAGE(PG8_SA(0, 1), cA, cva1);
        if (wr == 1) PG8_BAR;
        PG8_WAIT_V(2); PG8_BAR;
        PG8_STAGE(PG8_SB(1, 0), cB + kstep, voffB); PG8_STAGE(PG8_SA(1, 0), cA + kstepA, cva0); PG8_STAGE(PG8_SB(1, 1), cB + hstep + kstep, voffB);
        PG8_WAIT_V(6); PG8_BAR;
    } else {
        PG8_STAGE(PG8_SB(0, 0), cB, voffB); PG8_STAGE(PG8_SA(0, 0), cA, cva0); PG8_STAGE(PG8_SB(0, 1), cB + hstep, voffB); PG8_STAGE(PG8_SA(0, 1), cA, cva1);
        if (wr == 1) PG8_BAR;
        PG8_WAIT_V(4); PG8_BAR;
        PG8_STAGE(PG8_SB(1, 0), cB + kstep, voffB); PG8_STAGE(PG8_SA(1, 0), cA + kstepA, cva0); PG8_STAGE(PG8_SB(1, 1), cB + hstep + kstep, voffB);
        PG8_WAIT_V(6); PG8_BAR;
    }
    for (;;) {
        const bool has_next = S.next(ui + 1, nxt);
        const char* nA = (has_next && !GATHER) ? (const char*)g.A + (size_t)nxt.pm * tstepA : cA; const char* nB = has_next ? (const char*)g.Bt + (size_t)nxt.pn * tstep : cB;
        if constexpr (GATHER) { if (has_next) {
#pragma unroll
            for (int i = 0; i < 2; ++i) { nva0[i] = ((unsigned)gtab[nxt.pm * 256 + rA[i]] * (unsigned)LD) * 2u + cA2[i]; nva1[i] = ((unsigned)gtab[nxt.pm * 256 + 128 + rA[i]] * (unsigned)LD) * 2u + cA2[i]; } } }
        for (int t = 0; t < nt; t += 2) {
            const bool last = (t == nt - 2);
            const char* a1 = cA + (size_t)(t + 1) * kstepA;
            const char* a2 = last ? nA : cA + (size_t)(t + 2) * kstepA; const char* b2 = last ? nB : cB + (size_t)(t + 2) * kstep;
            const char* a3 = a2 + kstepA; const char* b3 = b2 + kstep;
            unsigned sva0[2], sva1[2];
#pragma unroll
            for (int i = 0; i < 2; ++i) { sva0[i] = (GATHER && last) ? nva0[i] : cva0[i]; sva1[i] = (GATHER && last) ? nva1[i] : cva1[i]; }
            if (last && has_next) S.a_ready(nxt);
            if constexpr (SP2) {
            PG8_LDB(B0, 0, 0); PG8_LDB(B1, 0, 1); PG8_SCHED; PG8_LDA(At, 0, 0); PG8_STAGE(PG8_SA(1, 1), a1, cva1);
            PG8_WAIT_V(8); PG8_WAIT_L(0); PG8_BAR; PG8_MMA(0, 0, At, B0); PG8_MMA(0, 1, At, B1); PG8_BAR; PG8_SCHED;
            PG8_LDA(At, 0, 1); PG8_STAGE(PG8_SB(0, 0), b2, voffB); PG8_STAGE(PG8_SB(0, 1), b2 + hstep, voffB); PG8_STAGE(PG8_SA(0, 0), a2, sva0);
            PG8_WAIT_V(8); PG8_WAIT_L(0); PG8_BAR; PG8_MMA(1, 0, At, B0); PG8_MMA(1, 1, At, B1); PG8_BAR; PG8_SCHED;
            PG8_LDB(B0, 1, 0); PG8_LDB(B1, 1, 1); PG8_SCHED; PG8_LDA(At, 1, 0); PG8_STAGE(PG8_SA(0, 1), a2, sva1);
            PG8_WAIT_V(8); PG8_WAIT_L(0); PG8_BAR; PG8_MMA(0, 0, At, B0); PG8_MMA(0, 1, At, B1); PG8_BAR; PG8_SCHED;
            PG8_LDA(At, 1, 1); PG8_STAGE(PG8_SB(1, 0), b3, voffB); PG8_STAGE(PG8_SB(1, 1), b3 + hstep, voffB); PG8_STAGE(PG8_SA(1, 0), a3, sva0);
            PG8_WAIT_V(8); PG8_WAIT_L(0); PG8_BAR; PG8_MMA(1, 0, At, B0); PG8_MMA(1, 1, At, B1); PG8_BAR; PG8_SCHED;
            } else {
            PG8_LDB(B0, 0, 0); PG8_SCHED; PG8_LDA(At, 0, 0); PG8_STAGE(PG8_SA(1, 1), a1, cva1);
            PG8_WAIT_L(8); PG8_BAR; PG8_WAIT_L(0); PG8_MMA(0, 0, At, B0); PG8_BAR; PG8_SCHED;
            PG8_LDB(B1, 0, 1); PG8_STAGE(PG8_SB(0, 0), b2, voffB);
            PG8_BAR; PG8_WAIT_L(0); PG8_MMA(0, 1, At, B1); PG8_BAR;
            PG8_LDA(At, 0, 1); PG8_STAGE(PG8_SA(0, 0), a2, sva0);
            PG8_BAR; PG8_WAIT_L(0); PG8_MMA(1, 0, At, B0); PG8_BAR; PG8_SCHED;
            PG8_STAGE(PG8_SB(0, 1), b2 + hstep, voffB);
            PG8_WAIT_V(6); PG8_BAR; PG8_MMA(1, 1, At, B1); PG8_BAR;
            PG8_LDB(B0, 1, 0); PG8_SCHED; PG8_LDA(At, 1, 0); PG8_STAGE(PG8_SA(0, 1), a2, sva1);
            PG8_WAIT_L(8); PG8_BAR; PG8_WAIT_L(0); PG8_MMA(0, 0, At, B0); PG8_BAR; PG8_SCHED;
            PG8_LDB(B1, 1, 1); PG8_STAGE(PG8_SB(1, 0), b3, voffB);
            PG8_BAR; PG8_WAIT_L(0); PG8_MMA(0, 1, At, B1); PG8_BAR;
            PG8_LDA(At, 1, 1); PG8_STAGE(PG8_SA(1, 0), a3, sva0);
            PG8_BAR; PG8_WAIT_L(0); PG8_MMA(1, 0, At, B0); PG8_BAR; PG8_SCHED;
            PG8_STAGE(PG8_SB(1, 1), b3 + hstep, voffB);
            PG8_WAIT_V(6); PG8_BAR; PG8_MMA(1, 1, At, B1); PG8_BAR;
            }
        }
        if constexpr (ALIGN_EPI) { if (wr == 0) PG8_BAR; }
        if constexpr (!Epi::AFTER_DRAIN) { E(acc, cur, wr, wc, fr, fq); S.done(cur); }
        if (!has_next) break;
#pragma unroll
        for (int a = 0; a < 2; ++a)
#pragma unroll
            for (int b = 0; b < 2; ++b)
#pragma unroll
                for (int m = 0; m < 4; ++m)
#pragma unroll
                    for (int n = 0; n < 2; ++n) acc[a][b][m][n] = (f32x4){0.f, 0.f, 0.f, 0.f};
        cur = nxt; cA = nA; cB = nB; ++ui;
#pragma unroll
        for (int i = 0; i < 2; ++i) { cva0[i] = nva0[i]; cva1[i] = nva1[i]; }
        if constexpr (ALIGN_EPI) { if (wr == 1) PG8_BAR; }
    }
    PG8_WAIT_V(0);
    if constexpr (!ALIGN_EPI) { if (wr == 0) PG8_BAR; }
    PG8_BAR;
    if constexpr (Epi::AFTER_DRAIN) { E.fused(acc, cur, wr, wc, fr, fq, lds, wid, lane); S.done(cur); }
#undef PG8_SA
#undef PG8_SB
#undef PG8_STAGE
#undef PG8_LDA
#undef PG8_LDB
#undef PG8_MMA
#undef PG8_WAIT_V
#undef PG8_WAIT_L
#undef PG8_BAR
#undef PG8_SCHED
}
}
constexpr size_t MiB = 1u << 20;
constexpr size_t WS_CTL = 0, CTL_ZERO_BYTES = 1 * MiB;
constexpr size_t WS_MODF = 1 * MiB;
constexpr size_t WS_LBV = 1 * MiB + 512 * 1024;
constexpr size_t WS_GATES = 2 * MiB;
constexpr size_t WS_TOPE = 5 * MiB;
constexpr size_t WS_TOPP = 5 * MiB + 256 * 1024;
constexpr size_t WS_WHIST = 6 * MiB;
constexpr size_t WS_META = 6 * MiB + 64 * 1024;
constexpr size_t WS_SLOTTOK = 6 * MiB + 128 * 1024;
constexpr size_t WS_TOKSLOT = 7 * MiB;
constexpr size_t WS_STATE = 8 * MiB;
constexpr size_t WS_XC = 24 * MiB;
constexpr size_t WS_CFB = 32 * MiB;
constexpr size_t WS_WIN0 = 40 * MiB, WS_WOUT0 = 48 * MiB, WS_FGU = 50 * MiB, WS_FDN = 61 * MiB, WS_WG = 66 * MiB + 512 * 1024;
constexpr size_t WS_WIN1 = 68 * MiB, WS_WOUT1 = 76 * MiB, WS_MGU = 78 * MiB, WS_MDN = 122 * MiB;
constexpr size_t WS_Z = 146 * MiB;
constexpr size_t WS_A1 = 418 * MiB;
constexpr size_t WS_FC = 486 * MiB, WS_HC = 490 * MiB, WS_F2C = 502 * MiB;
constexpr size_t WS_END = 506 * MiB;
constexpr size_t ZOFF_F2 = 192 * MiB, ZOFF_OPERM = 182 * MiB;
constexpr int CW_BAR = 4096;
constexpr int CW_CC = 8192, CW_SUB = 8256, CW_IP2 = 8320  , CW_MFULL = 8448, CW_MTAIL = 8512  , CW_BAR2 = 12288;

constexpr int RING_BYTES = 131072;
constexpr int LDSCTL_OFF = 163840 - 4096, MISC_OFF = LDSCTL_OFF + 320;
constexpr int LDS_BYTES = 163840;

#define GAS __attribute__((address_space(1)))
#define LAS __attribute__((address_space(3)))
typedef unsigned short bf16;
typedef unsigned v4u __attribute__((ext_vector_type(4)));
typedef unsigned v2u __attribute__((ext_vector_type(2)));
typedef float f32x4 __attribute__((ext_vector_type(4)));
typedef float f32x2 __attribute__((ext_vector_type(2)));
typedef GAS unsigned gu32;
#define LDS_WAIT() asm volatile("s_waitcnt lgkmcnt(0)" ::: "memory")
#define VM_WAIT() asm volatile("s_waitcnt vmcnt(0)" ::: "memory")
__device__ __forceinline__ unsigned f2bf(float f) { unsigned u = __builtin_bit_cast(unsigned, f); return (u + 0x7fffu + ((u >> 16) & 1u)) >> 16; }
__device__ __forceinline__ unsigned pk2(float lo, float hi) { return pg8::cvt_pk_bf16(lo, hi); }
__device__ __forceinline__ float bf_lo(unsigned w) { return __builtin_bit_cast(float, w << 16); }
__device__ __forceinline__ float bf_hi(unsigned w) { return __builtin_bit_cast(float, w & 0xffff0000u); }
typedef _Float16 h16x2 __attribute__((ext_vector_type(2)));
__device__ __forceinline__ unsigned pkh(float lo, float hi) { return __builtin_bit_cast(unsigned, __builtin_convertvector((f32x2){lo, hi}, h16x2)); }
__device__ __forceinline__ f32x2 unh(unsigned w) { return __builtin_convertvector(__builtin_bit_cast(h16x2, w), f32x2); }
__device__ __forceinline__ float bf1(bf16 b) { return __builtin_bit_cast(float, ((unsigned)b) << 16); }
__device__ __forceinline__ float sigmoidf_(float x) { return 1.0f / (1.0f + __expf(-x)); }
#define DPP_F(old_, src_, ctrl_, rm_) __builtin_bit_cast(float, __builtin_amdgcn_update_dpp(__builtin_bit_cast(int, (old_)), __builtin_bit_cast(int, (src_)), (ctrl_), (rm_), 0xf, false))
__device__ __forceinline__ float wave_scan_add(float x) {
    x += DPP_F(0.f, x, 0x111, 0xf); x += DPP_F(0.f, x, 0x112, 0xf); x += DPP_F(0.f, x, 0x114, 0xf); x += DPP_F(0.f, x, 0x118, 0xf);
    x += DPP_F(0.f, x, 0x142, 0xa); x += DPP_F(0.f, x, 0x143, 0xc); return x;
}
__device__ __forceinline__ float wave_scan_max(float x) {
    const float ninf = -3.0e38f;
    x = fmaxf(x, DPP_F(ninf, x, 0x111, 0xf)); x = fmaxf(x, DPP_F(ninf, x, 0x112, 0xf)); x = fmaxf(x, DPP_F(ninf, x, 0x114, 0xf)); x = fmaxf(x, DPP_F(ninf, x, 0x118, 0xf));
    x = fmaxf(x, DPP_F(ninf, x, 0x142, 0xa)); x = fmaxf(x, DPP_F(ninf, x, 0x143, 0xc)); return x;
}
__device__ __forceinline__ int wave_sum_i(int x) {
#define DPP_I(src_, ctrl_, rm_) __builtin_amdgcn_update_dpp(0, (src_), (ctrl_), (rm_), 0xf, false)
    x += DPP_I(x, 0x111, 0xf); x += DPP_I(x, 0x112, 0xf); x += DPP_I(x, 0x114, 0xf); x += DPP_I(x, 0x118, 0xf); x += DPP_I(x, 0x142, 0xa); x += DPP_I(x, 0x143, 0xc);
#undef DPP_I
    return __builtin_amdgcn_readlane(x, 63);
}
__device__ __forceinline__ float wave_sum(float v) { return __builtin_bit_cast(float, __builtin_amdgcn_readlane(__builtin_bit_cast(int, wave_scan_add(v)), 63)); }
#define XB_TMO      128
#define XB_XCNT(j)  (256  + 64 * (j))
#define XB_XSUB(j)  (1280 + 64 * (j))
#define XB_XGEN(j)  (2304 + 64 * (j))
#define XB_TOP      3328
#define XB_TOPGEN   3392
#define XCD_BAR_WORDS 3456
#define XB_SPIN_CAP (1u << 18)

__device__ __forceinline__ unsigned xb_ld(unsigned* p)              { return __hip_atomic_load(p, __ATOMIC_RELAXED, __HIP_MEMORY_SCOPE_AGENT); }
__device__ __forceinline__ unsigned xb_add(unsigned* p, unsigned v) { return __hip_atomic_fetch_add(p, v, __ATOMIC_RELAXED, __HIP_MEMORY_SCOPE_AGENT); }
__device__ __forceinline__ unsigned xb_xcc_id() { return (unsigned)__builtin_amdgcn_s_getreg((3 << 11) | 20) & 0xFu; }
#define XB_SPIN(cond, bar) do { unsigned _sp = 0; while (cond) { __builtin_amdgcn_s_sleep(1); \
    if ((++_sp & 255u) == 0u) { if (xb_ld(&(bar)[XB_TMO])) break; if (_sp > XB_SPIN_CAP) { atomicAdd(&(bar)[XB_TMO], 1u); break; } } } } while (0)

struct XcdBarrier {
    unsigned* bar; unsigned x;
    unsigned members;
    volatile LAS unsigned* st;
};

__device__ __forceinline__ XcdBarrier xcd_barrier_post(unsigned* bar, volatile LAS unsigned* st, bool leader) {
    XcdBarrier b; b.bar = bar; b.x = xb_xcc_id(); b.st = st; b.members = 0u;
    if (leader) (void)xb_add(&bar[XB_XCNT(b.x)], 1u);
    return b;
}
__device__ __forceinline__ void xcd_barrier_complete(unsigned* bar, unsigned x, unsigned& nloc, unsigned& nx, unsigned members) {
    const unsigned G = members ? members : gridDim.x * gridDim.y * gridDim.z;
    unsigned sum, cnt, mine, sp = 0u;
    for (;;) {
        sum = 0u; cnt = 0u; mine = 0u;
#pragma unroll
        for (unsigned j = 0; j < 16; ++j) { const unsigned c = xb_ld(&bar[XB_XCNT(j)]); sum += c; cnt += (c > 0u) ? 1u : 0u; mine = (j == x) ? c : mine; }
        if (sum == G) break;
        __builtin_amdgcn_s_sleep(1);
        if ((++sp & 255u) == 0u) { if (xb_ld(&bar[XB_TMO])) break; if (sp > XB_SPIN_CAP) { atomicAdd(&bar[XB_TMO], 1u); break; } }
    }
    nloc = mine > 0u ? mine : 1u; nx = cnt > 0u ? cnt : 1u;
}

__device__ __forceinline__ void xcd_barrier(const XcdBarrier& b, bool leader) {
    asm volatile("s_waitcnt vmcnt(0)" ::: "memory");
    __syncthreads();
    if (leader) {
        unsigned* bar = b.bar; unsigned bx = b.x; asm volatile("" : "+v"(bx));
        __builtin_amdgcn_s_waitcnt(0);
        unsigned nloc = b.st[0], nx = b.st[1];
        if (nloc == 0u) { xcd_barrier_complete(bar, bx, nloc, nx, b.members); b.st[0] = nloc; b.st[1] = nx; }
        const unsigned old = xb_add(&bar[XB_XSUB(bx)], 1u);
        const unsigned gen = old / nloc;
        if (old + 1u == (gen + 1u) * nloc) {
            __builtin_amdgcn_fence(__ATOMIC_RELEASE, "agent");
            asm volatile("s_waitcnt vmcnt(0)" ::: "memory");
            const unsigned og = xb_add(&bar[XB_TOP], 1u);
            const unsigned tg = og / nx;
            if (og + 1u == (tg + 1u) * nx) xb_add(&bar[XB_TOPGEN], 1u);
            else XB_SPIN(xb_ld(&bar[XB_TOPGEN]) == tg, bar);
            __builtin_amdgcn_fence(__ATOMIC_ACQUIRE, "agent");
            xb_add(&bar[XB_XGEN(bx)], 1u);
            asm volatile("s_waitcnt vmcnt(0)" ::: "memory");
        } else {
            XB_SPIN(xb_ld(&bar[XB_XGEN(bx)]) == gen, bar);
            __builtin_amdgcn_fence(__ATOMIC_ACQUIRE, "agent");
            asm volatile("s_waitcnt vmcnt(0)" ::: "memory");
        }
    }
    __syncthreads();
}
struct Args { const float* in[22]; float* out; unsigned char* ws; int code, layer, expert, single; };
enum { IN_X = 0, IN_C, IN_CTX, IN_CCTX, IN_WADA, IN_BADA, IN_WIN, IN_CONVW, IN_CONVB, IN_HLB, IN_GBIAS, IN_HGNORM, IN_MLNORM, IN_WOUT, IN_LNG, IN_LNB,
       IN_FGU, IN_FDN, IN_RW, IN_RB, IN_MGU, IN_MDN };
enum { PH_P0 = 0, PH_P1, PH_INPROJ, PH_SCAN_A, PH_SCAN_B, PH_OUTPROJ, PH_RESLN1, PH_FFNUP, PH_FFNDN, PH_RESLN2, PH_MOEUP, PH_MOEDN, PH_MOEACC, PH_FINAL };
constexpr int PTAB_OFF = LDSCTL_OFF + 1024;
struct Frame {
    LAS unsigned char* lds;
    int tid, lane, wave, bid, G;
    unsigned char* ws;
    __device__ __forceinline__ const float* in(int i) const { const unsigned long long v = ((const LAS unsigned long long*)(lds + PTAB_OFF))[i];
        const unsigned lo = __builtin_amdgcn_readfirstlane((unsigned)v), hi = __builtin_amdgcn_readfirstlane((unsigned)(v >> 32)); return (const float*)(((unsigned long long)hi << 32) | lo); }
};
__device__ __forceinline__ Frame phase_frame(const Frame& F0) {
    Frame F = F0; int lid; asm volatile("v_mbcnt_lo_u32_b32 %0, -1, 0\n\tv_mbcnt_hi_u32_b32 %0, -1, %0" : "=v"(lid));
    int t = F0.wave * 64 + lid, b = F0.bid; unsigned long long w = (unsigned long long)F0.ws; unsigned lb = (unsigned)(unsigned long long)F0.lds;
    asm volatile("" : "+v"(t)); asm volatile("" : "+s"(b)); asm volatile("" : "+s"(w)); asm volatile("" : "+s"(lb));
    F.tid = t; F.lane = t & 63; F.wave = __builtin_amdgcn_readfirstlane(t >> 6); F.bid = b; F.ws = (unsigned char*)w; F.lds = (LAS unsigned char*)lb; return F;
}

__device__ __forceinline__ void transpose_item(const float* W, int ldn, int k0, int src_col0, bf16* WT, int ldk, int dst_row0, LAS float* scr, int lane) {
    float tv[32];
    const float* wp = W + (size_t)(k0 + (lane >> 5)) * ldn + src_col0 + (lane & 31);
#pragma unroll
    for (int i = 0; i < 32; ++i) tv[i] = wp[(size_t)(2 * i) * ldn];
#pragma unroll
    for (int i = 0; i < 32; ++i) scr[(2 * i + (lane >> 5)) * 33 + (lane & 31)] = tv[i];
    LDS_WAIT(); asm volatile("" ::: "memory");
    const int c = lane & 7;
#pragma unroll
    for (int j = 0; j < 4; ++j) { const int n = (lane >> 3) + 8 * j; const LAS float* s = scr + (8 * c) * 33 + n;
        v4u o; o.x = pk2(s[0 * 33], s[1 * 33]); o.y = pk2(s[2 * 33], s[3 * 33]); o.z = pk2(s[4 * 33], s[5 * 33]); o.w = pk2(s[6 * 33], s[7 * 33]);
        *(GAS v4u*)(WT + (size_t)(dst_row0 + n) * ldk + k0 + 8 * c) = o; }
    LDS_WAIT(); asm volatile("" ::: "memory");
}
constexpr int T_WIN = 16 * 128, T_WOUT = 16 * 32, T_FGU = 16 * 176, T_FDN = 44 * 32, T_MGU = 8 * 16 * 88, T_MDN = 8 * 22 * 32;
constexpr int T_TOTAL = 2 * T_WIN + 2 * T_WOUT + T_FGU + T_FDN + T_MGU + T_MDN;
__device__ __forceinline__ void weight_item(const Frame& F, int r, LAS float* scr) {
    unsigned char* ws = F.ws;
#pragma unroll 1
    for (int l = 0; l < 2; ++l) {
        if (r < T_WIN) { const int nb = r % 128, kb = r / 128;
            transpose_item(F.in(IN_WIN) + (size_t)l * 1024 * PROJ, PROJ, 64 * kb, 32 * nb + (nb >= 112 ? 16 : 0), (bf16*)(ws + (l ? WS_WIN1 : WS_WIN0)), 1024, 32 * nb, scr, F.lane); return; }
        r -= T_WIN;
        if (r < T_WOUT) { const int nb = r % 32, kb = r / 32;
            transpose_item(F.in(IN_WOUT) + (size_t)l * 1024 * 1024, 1024, 64 * kb, 32 * nb, (bf16*)(ws + (l ? WS_WOUT1 : WS_WOUT0)), 1024, 32 * nb, scr, F.lane); return; }
        r -= T_WOUT;
        if (l == 0) {
            if (r < T_FGU) { const int nb = r % 176, kb = r / 176, pn = nb >> 3, bj = (nb >> 2) & 1, jb = nb & 3;
                transpose_item(F.in(IN_FGU), 2 * DFF, 64 * kb, bj * DFF + 128 * pn + 32 * jb, (bf16*)(ws + WS_FGU), 1024, 32 * nb, scr, F.lane); return; }
            r -= T_FGU;
            if (r < T_FDN) { const int nb = r % 32, kb = r / 32;
                transpose_item(F.in(IN_FDN), 1024, 64 * kb, 32 * nb, (bf16*)(ws + WS_FDN), DFF, 32 * nb, scr, F.lane); return; }
            r -= T_FDN;
        } else {
            if (r < T_MGU) { const int e = r / 1408, rr = r % 1408, nb = rr % 88, kb = rr / 88, pn = nb >> 3, bj = (nb >> 2) & 1, jb = nb & 3;
                transpose_item(F.in(IN_MGU) + (size_t)e * 1024 * 2 * DEXP, 2 * DEXP, 64 * kb, bj * DEXP + 128 * pn + 32 * jb, (bf16*)(ws + WS_MGU) + (size_t)e * 2 * DEXP * 1024, 1024, 32 * nb, scr, F.lane); return; }
            r -= T_MGU;
            if (r < T_MDN) { const int e = r / 704, rr = r % 704, nb = rr % 32, kb = rr / 32;
                transpose_item(F.in(IN_MDN) + (size_t)e * DEXP * 1024, 1024, 64 * kb, 32 * nb, (bf16*)(ws + WS_MDN) + (size_t)e * 1024 * DEXP, DEXP, 32 * nb, scr, F.lane); return; }
        }
    }
}
constexpr int T_L0 = T_WIN + T_WOUT + T_FGU + T_FDN, T_L1 = T_WIN + T_WOUT + T_MGU + T_MDN;
constexpr int T_L1A = T_L0 + T_WIN + T_WOUT;
__device__ __forceinline__ void convert_layer1_weights(const Frame& F, int first_bid, int nblocks, int it_lo, int it_hi) {
    LAS float* scr = (LAS float*)(F.lds + F.wave * 16384);
    const int gw = (F.bid - first_bid) * NWAVES + F.wave, NGW = nblocks * NWAVES;
    for (int it = it_lo + gw; it < it_hi; it += NGW) weight_item(F, it, scr);
}
__device__ __forceinline__ void phase_p0(const Frame& F) {
    unsigned char* ws = F.ws;
    if (F.bid < 192) {
        LAS float* cond = (LAS float*)F.lds;
        LAS float* red = (LAS float*)(F.lds + 36864);
        for (int i = F.tid; i < 9 * 1024; i += NTHREADS) { const int r = i >> 10, k = i & 1023; const float c = r < 8 ? F.in(IN_C)[r * 1024 + k] : F.in(IN_CCTX)[k]; cond[i] = c * sigmoidf_(c); }
        __syncthreads();
        for (int it = F.bid; it < 192; it += F.G) {
            const int l = it / 96, col0 = (it % 96) * 64, c = F.tid & 63, kg = F.tid >> 6;
            float acc[9];
#pragma unroll
            for (int r = 0; r < 9; ++r) acc[r] = 0.f;
            const float* wp = F.in(IN_WADA) + ((size_t)l * 1024 + kg * 128) * 6144 + col0 + c;
#pragma unroll 4
            for (int k = 0; k < 128; ++k) { const float w = wp[(size_t)k * 6144];
#pragma unroll
                for (int r = 0; r < 9; ++r) acc[r] += cond[r * 1024 + kg * 128 + k] * w; }
#pragma unroll
            for (int r = 0; r < 9; ++r) red[(kg * 9 + r) * 64 + c] = acc[r];
            __syncthreads();
            for (int o = F.tid; o < 576; o += NTHREADS) { const int r = o >> 6, cc = o & 63; float s = F.in(IN_BADA)[l * 6144 + col0 + cc];
#pragma unroll
                for (int g = 0; g < 8; ++g) s += red[(g * 9 + r) * 64 + cc];
                ((float*)(ws + WS_MODF))[(l * 9 + r) * 6144 + col0 + cc] = s; }
            __syncthreads();
        }
    }
    { const int gid = F.bid * NTHREADS + F.tid;
      if (gid < 2048) { const int l = gid >> 10, dir = (gid >> 9) & 1, i = gid & 511; float v = 0.f;
          if (l == 1) { const float h0 = F.in(IN_HLB)[(0 * 2 + dir) * 512 + i], h1 = F.in(IN_HLB)[(1 * 2 + dir) * 512 + i]; v = 1.0f / (1.0f + __expf(h0 - h1)); }
          ((float*)(ws + WS_LBV))[gid] = v; }
      else if (gid < 2048 + 32768) { const int idx = gid - 2048, l = idx >> 14, g = (idx >> 10) & 15, k = idx & 1023;
          ((bf16*)(ws + WS_WG))[idx] = (bf16)f2bf(F.in(IN_WIN)[((size_t)l * 1024 + k) * PROJ + 3584 + g]); } }
}
__device__ __forceinline__ void convert_layer0_weights(const Frame& F) {
    __syncthreads();
    LAS float* scr = (LAS float*)(F.lds + F.wave * 16384);
    const int gw = F.bid * NWAVES + F.wave, NGW = F.G * NWAVES;
    for (int it = gw; it < T_WIN + T_WOUT; it += NGW) weight_item(F, it, scr);
}

struct RowVecs { f32x4 gate[4], lng[4], lnb[4], sc[4], sh[4]; };
struct RowIn { f32x4 v[4]; v2u xb[4], f1[4], f2[4]; f32x2 pp; };
template <bool HAS_BR, int MOE, bool XIN_BF = false>
__device__ __forceinline__ RowIn row_load(const Frame& F, const float* xrow, const bf16* frow, int rowid) {
    RowIn R;
    if (XIN_BF) { const GAS v2u* xr = (const GAS v2u*)xrow + F.lane;
#pragma unroll
        for (int j = 0; j < 4; ++j) R.xb[j] = xr[64 * j]; }
    else { const GAS f32x4* xr = (const GAS f32x4*)xrow + F.lane;
#pragma unroll
        for (int j = 0; j < 4; ++j) R.v[j] = xr[64 * j]; }
    if (HAS_BR && MOE != 2) { const GAS v2u* fr = (const GAS v2u*)frow + F.lane;
#pragma unroll
        for (int j = 0; j < 4; ++j) R.f1[j] = fr[64 * j]; }
    if (HAS_BR && MOE == 2) {
        const int s1 = __builtin_amdgcn_readfirstlane(((const int*)(F.ws + WS_TOKSLOT))[2 * rowid]), s2 = __builtin_amdgcn_readfirstlane(((const int*)(F.ws + WS_TOKSLOT))[2 * rowid + 1]);
        R.pp = ((const f32x2*)(F.ws + WS_TOPP))[rowid];
        const GAS v2u* f1 = (const GAS v2u*)(frow + (size_t)s1 * DM) + F.lane; const GAS v2u* f2 = (const GAS v2u*)(frow + (size_t)s2 * DM) + F.lane;
#pragma unroll
        for (int j = 0; j < 4; ++j) { R.f1[j] = f1[64 * j]; R.f2[j] = f2[64 * j]; } }
    return R;
}
template <bool HAS_BR, bool HAS_LN, bool HAS_XOUT, bool HAS_HX, int MOE, bool XIN_BF = false, bool XOUT_BF = false>
__device__ __forceinline__ int row_one(const Frame& F, const RowVecs& V, const RowIn& R, float* orow, bf16* hrow, int rowid, const LAS float* rw) {
    int te_ret = 0;
    f32x4 v[4];
#pragma unroll
    for (int j = 0; j < 4; ++j) { if (XIN_BF) { const v2u w = R.xb[j]; const f32x2 a = unh(w.x), c = unh(w.y); v[j] = (f32x4){a.x, a.y, c.x, c.y}; } else v[j] = R.v[j]; }
    if (HAS_BR && MOE != 2) {
#pragma unroll
        for (int j = 0; j < 4; ++j) { const v2u w = R.f1[j]; const f32x4 f = (f32x4){bf_lo(w.x), bf_hi(w.x), bf_lo(w.y), bf_hi(w.y)}; v[j] = v[j] * DN_ALPHA + V.gate[j] * f; }
    }
    if (HAS_BR && MOE == 2) {
#pragma unroll
        for (int j = 0; j < 4; ++j) { const v2u a = R.f1[j], c = R.f2[j];
            const f32x4 f = (f32x4){bf_lo(a.x), bf_hi(a.x), bf_lo(a.y), bf_hi(a.y)} * R.pp.x + (f32x4){bf_lo(c.x), bf_hi(c.x), bf_lo(c.y), bf_hi(c.y)} * R.pp.y; v[j] = v[j] * DN_ALPHA + V.gate[j] * f; }
    }
    if (HAS_LN) {
        float s = 0.f;
#pragma unroll
        for (int j = 0; j < 4; ++j) s += (v[j].x + v[j].y) + (v[j].z + v[j].w);
        const float mean = wave_sum(s) * (1.f / DM); float s2 = 0.f;
#pragma unroll
        for (int j = 0; j < 4; ++j) { v[j] = v[j] - mean; s2 += (v[j].x * v[j].x + v[j].y * v[j].y) + (v[j].z * v[j].z + v[j].w * v[j].w); }
        const float rstd = 1.0f / sqrtf(wave_sum(s2) * (1.f / DM) + LN_EPS);
#pragma unroll
        for (int j = 0; j < 4; ++j) v[j] = v[j] * rstd * V.lng[j] + V.lnb[j];
    }
    if (HAS_XOUT && XOUT_BF) { GAS v2u* o = (GAS v2u*)orow + F.lane;
#pragma unroll
        for (int j = 0; j < 4; ++j) { v2u w; w.x = pkh(v[j].x, v[j].y); w.y = pkh(v[j].z, v[j].w); o[64 * j] = w; } }
    if (HAS_XOUT && !XOUT_BF) { GAS f32x4* o = (GAS f32x4*)orow + F.lane;
#pragma unroll
        for (int j = 0; j < 4; ++j) o[64 * j] = v[j]; }
    if (HAS_HX) {
        f32x4 h[4];
#pragma unroll
        for (int j = 0; j < 4; ++j) h[j] = v[j] * (1.0f + V.sc[j]) + V.sh[j];
        GAS v2u* o = (GAS v2u*)hrow + F.lane;
#pragma unroll
        for (int j = 0; j < 4; ++j) { v2u w; w.x = pk2(h[j].x, h[j].y); w.y = pk2(h[j].z, h[j].w); o[64 * j] = w; }
        if (MOE == 1) {
            float lg[8];
#pragma unroll
            for (int e = 0; e < 8; ++e) lg[e] = 0.f;
#pragma unroll
            for (int j = 0; j < 4; ++j) { asm volatile("" ::: "memory");
#pragma unroll
                for (int q = 0; q < 4; ++q) { const int col = 4 * F.lane + 256 * j + q; const f32x4 w0 = *(const LAS f32x4*)(rw + col * 8), w1 = *(const LAS f32x4*)(rw + col * 8 + 4); const float hv = h[j][q];
                    lg[0] += hv * w0.x; lg[1] += hv * w0.y; lg[2] += hv * w0.z; lg[3] += hv * w0.w; lg[4] += hv * w1.x; lg[5] += hv * w1.y; lg[6] += hv * w1.z; lg[7] += hv * w1.w; } }
#pragma unroll
            for (int e = 0; e < 8; ++e) lg[e] = wave_sum(lg[e]) + F.in(IN_RB)[e];
            int e1 = 0; float v1 = lg[0];
#pragma unroll
            for (int e = 1; e < 8; ++e) if (lg[e] > v1) { v1 = lg[e]; e1 = e; }
            int e2 = -1; float v2 = -3.0e38f;
#pragma unroll
            for (int e = 0; e < 8; ++e) if (e != e1 && lg[e] > v2) { v2 = lg[e]; e2 = e; }
            const float p1 = 1.0f / (1.0f + __expf(v2 - v1));
            if (F.lane == 0) { ((int*)(F.ws + WS_TOPE))[rowid] = e1 | (e2 << 8); ((f32x2*)(F.ws + WS_TOPP))[rowid] = (f32x2){p1, 1.0f - p1}; }
            te_ret = e1 | (e2 << 8);
        }
    }
    return te_ret;
}
template <bool HAS_BR, bool HAS_LN, bool HAS_XOUT, bool HAS_HX, int MOE, bool XIN_BF = false, bool XOUT_BF = false>
__device__ __forceinline__ void row_phase(const Frame& F, int l, int sub, const float* xlat, const float* xctx, const bf16* fbr, float* olat, float* octx, bf16* hx, int hl, bool do_ctx) {
    const float* modf = (const float*)(F.ws + WS_MODF);
    const LAS float* rw = (const LAS float*)F.lds;
    if (MOE == 1) { for (int i = F.tid; i < 8192; i += NTHREADS) ((LAS float*)F.lds)[i] = F.in(IN_RW)[i]; __syncthreads(); }
    const int gidx = sub ? 5 : 2, shidx = sub ? 0 : 3;
#pragma unroll 1
    for (int seg = 0; seg < 2; ++seg) {
        if (seg == 1 && !do_ctx) break;
        const int r = seg ? 8 : (F.bid >> 5);
        RowVecs V;
#pragma unroll
        for (int j = 0; j < 4; ++j) { const int c = 4 * F.lane + 256 * j;
            V.gate[j] = HAS_BR ? *(const f32x4*)(modf + (l * 9 + r) * 6144 + gidx * 1024 + c) : (f32x4){0.f, 0.f, 0.f, 0.f};
            V.lng[j] = HAS_LN ? *(const f32x4*)(F.in(IN_LNG) + (l * 2 + sub) * 1024 + c) : (f32x4){0.f, 0.f, 0.f, 0.f};
            V.lnb[j] = HAS_LN ? *(const f32x4*)(F.in(IN_LNB) + (l * 2 + sub) * 1024 + c) : (f32x4){0.f, 0.f, 0.f, 0.f};
            V.sh[j] = HAS_HX ? *(const f32x4*)(modf + (hl * 9 + r) * 6144 + shidx * 1024 + c) : (f32x4){0.f, 0.f, 0.f, 0.f};
            V.sc[j] = HAS_HX ? *(const f32x4*)(modf + (hl * 9 + r) * 6144 + (shidx + 1) * 1024 + c) : (f32x4){0.f, 0.f, 0.f, 0.f}; }
        if (seg == 0) {
            int cnt[8];
#pragma unroll
            for (int e = 0; e < 8; ++e) cnt[e] = 0;
            const int row0 = F.bid * 128 + F.wave * 16; const bf16* fb0 = (MOE == 2) ? fbr : fbr + (size_t)row0 * DM; const size_t fstep = (MOE == 2) ? 0 : DM;
            RowIn RA = row_load<HAS_BR, MOE, XIN_BF>(F, xlat + (size_t)row0 * DM, fb0, row0), RB = row_load<HAS_BR, MOE, XIN_BF>(F, xlat + (size_t)(row0 + 1) * DM, fb0 + fstep, row0 + 1);
#pragma unroll 1
            for (int i = 0; i < 16; i += 2) {
#pragma unroll
                for (int ab = 0; ab < 2; ++ab) { const int row = row0 + i + ab;
                    const int te = row_one<HAS_BR, HAS_LN, HAS_XOUT, HAS_HX, MOE, XIN_BF, XOUT_BF>(F, V, ab ? RB : RA, olat + (size_t)row * DM, hx + (size_t)row * DM, row, rw);
                    if (i + 2 < 16) { if (ab) RB = row_load<HAS_BR, MOE, XIN_BF>(F, xlat + (size_t)(row + 2) * DM, fb0 + (size_t)(i + ab + 2) * fstep, row + 2); else RA = row_load<HAS_BR, MOE, XIN_BF>(F, xlat + (size_t)(row + 2) * DM, fb0 + (size_t)(i + ab + 2) * fstep, row + 2); }
                    if (MOE == 1) { const int e1 = __builtin_amdgcn_readfirstlane(te) & 255, e2 = __builtin_amdgcn_readfirstlane(te) >> 8;
#pragma unroll
                        for (int e = 0; e < 8; ++e) cnt[e] += (e1 == e ? 1 : 0) + (e2 == e ? 1 : 0); } } }
            if (MOE == 1) { int vsel = 0;
#pragma unroll
                for (int e = 0; e < 8; ++e) vsel = (F.lane == e) ? cnt[e] : vsel;
                if (F.lane < 8) ((int*)(F.ws + WS_WHIST))[(F.bid * 8 + F.wave) * 8 + F.lane] = vsel; }
        } else {
            const int cr = F.bid * 8 + F.wave, row = M_LAT + cr;
            const RowIn RC = row_load<HAS_BR, 0>(F, xctx + (size_t)cr * DM, fbr + (size_t)row * DM, row);
            row_one<HAS_BR, HAS_LN, HAS_XOUT, HAS_HX, 0>(F, V, RC, octx + (size_t)cr * DM, hx + (size_t)row * DM, row, rw);
        }
    }
}

typedef short bf16x8g __attribute__((ext_vector_type(8)));
__device__ __forceinline__ void gates_mfma(const Frame& F, int l, int first_bid, int nblocks, int grp0, int grp1) {
    const bf16* hx = (const bf16*)(F.ws + WS_A1); const bf16* wg = (const bf16*)(F.ws + WS_WG) + (size_t)l * 16 * 1024;
    float* gates = (float*)(F.ws + WS_GATES); const float* gb = F.in(IN_GBIAS) + l * 16;
    const int r16 = F.lane & 15, kq = F.lane >> 4; const float bias = gb[r16];
    for (int grp = grp0 + (F.bid - first_bid) * NWAVES + F.wave; grp < grp1; grp += nblocks * NWAVES) {
        const GAS v4u* ap = (const GAS v4u*)(hx + (size_t)(grp * 16 + r16) * DM + 8 * kq); const GAS v4u* bp = (const GAS v4u*)(wg + (size_t)r16 * DM + 8 * kq);
        f32x4 acc = {0.f, 0.f, 0.f, 0.f};
#pragma unroll 1
        for (int kb = 0; kb < 4; ++kb) { v4u a[8], b[8];
#pragma unroll
            for (int k = 0; k < 8; ++k) { a[k] = ap[(kb * 8 + k) * 4]; b[k] = bp[(kb * 8 + k) * 4]; }
#pragma unroll
            for (int k = 0; k < 8; ++k) acc = __builtin_amdgcn_mfma_f32_16x16x32_bf16(__builtin_bit_cast(bf16x8g, a[k]), __builtin_bit_cast(bf16x8g, b[k]), acc, 0, 0, 0); }
#pragma unroll
        for (int r = 0; r < 4; ++r) { float v = acc[r] + bias; if ((r16 >> 2) & 1) v = fminf(v, 0.f) - log1pf(__expf(-fabsf(v))); gates[(size_t)(grp * 16 + 4 * kq + r) * 16 + r16] = v; }
    }
}

__device__ __forceinline__ int chain_row(int b, int dir, int s, int i, bool& is_ctx, int& tglob) {
    const int t = dir ? 63 - i : i;
    if (s < 4) { is_ctx = true; const int ch = dir ? 3 - s : s; tglob = ch * 64 + t; return M_LAT + b * CTXL + ch * 64 + t; }
    is_ctx = false; const int ch = dir ? 67 - s : s - 4; tglob = t; return b * SEQ + ch * 64 + t;
}

__device__ __forceinline__ void phase_moe_dispatch(const Frame& F) {
    const int* whist = (const int*)(F.ws + WS_WHIST); int* slot_tok = (int*)(F.ws + WS_SLOTTOK); int* tok_slot = (int*)(F.ws + WS_TOKSLOT); int* meta = (int*)(F.ws + WS_META);
    LAS int* red = (LAS int*)F.lds;
    LAS int* fin = red + 128;
    LAS int* sbase = fin + 16;
    LAS int* segs = sbase + 8;
    const int gw0 = F.bid * 8;
    int all[8], pre[8];
#pragma unroll
    for (int e = 0; e < 8; ++e) { all[e] = 0; pre[e] = 0; }
#pragma unroll
    for (int k = 0; k < 4; ++k) { const int idx = F.tid + 512 * k; const v4u a = *(const GAS v4u*)(whist + idx * 8), c = *(const GAS v4u*)(whist + idx * 8 + 4); const int m = idx < gw0 ? 1 : 0;
        all[0] += a.x; all[1] += a.y; all[2] += a.z; all[3] += a.w; all[4] += c.x; all[5] += c.y; all[6] += c.z; all[7] += c.w;
        pre[0] += m * (int)a.x; pre[1] += m * (int)a.y; pre[2] += m * (int)a.z; pre[3] += m * (int)a.w; pre[4] += m * (int)c.x; pre[5] += m * (int)c.y; pre[6] += m * (int)c.z; pre[7] += m * (int)c.w; }
#pragma unroll
    for (int e = 0; e < 8; ++e) { all[e] = wave_sum_i(all[e]); pre[e] = wave_sum_i(pre[e]); }
    if (F.lane == 0) {
#pragma unroll
        for (int e = 0; e < 8; ++e) { red[F.wave * 16 + e] = all[e]; red[F.wave * 16 + 8 + e] = pre[e]; } }
    __syncthreads();
    if (F.tid < 16) { int s = 0;
#pragma unroll
        for (int w = 0; w < 8; ++w) s += red[w * 16 + F.tid];
        fin[F.tid] = s; }
    __syncthreads();
    if (F.tid == 0) { int acc = 0;
        for (int e = 0; e < 8; ++e) { segs[e] = acc; segs[8 + e] = fin[e]; sbase[e] = acc + fin[8 + e]; if (F.bid == 0) meta[e] = acc >> 8; acc += (fin[e] + 255) & ~255; }
        if (F.bid == 0) meta[8] = acc >> 8; }
    __syncthreads();
    if (F.bid == 0) {
        for (int e = 0; e < 8; ++e) { const int s0 = segs[e] + segs[8 + e], s1 = segs[e] + ((segs[8 + e] + 255) & ~255);
            for (int s = s0 + F.tid; s < s1; s += NTHREADS) slot_tok[s] = 0; } }
    const int hv = whist[gw0 * 8 + F.lane];
    const int tok0 = F.bid * 128 + F.wave * 16;
    const int tev = (F.lane < 16) ? ((const int*)(F.ws + WS_TOPE))[tok0 + F.lane] : 0;
    int wb[8];
#pragma unroll
    for (int e = 0; e < 8; ++e) { int b = sbase[e];
#pragma unroll
        for (int w2 = 0; w2 < 7; ++w2) { const int hv2 = __builtin_amdgcn_readlane(hv, w2 * 8 + e); b += (w2 < F.wave) ? hv2 : 0; }
        wb[e] = b; }
    int s1v = 0, s2v = 0;
#pragma unroll
    for (int i = 0; i < 16; ++i) { const int te = __builtin_amdgcn_readlane(tev, i); const int e1 = te & 255, e2 = te >> 8; int s1 = 0, s2 = 0;
#pragma unroll
        for (int e = 0; e < 8; ++e) { if (e1 == e) { s1 = wb[e]; wb[e] += 1; } if (e2 == e) { s2 = wb[e]; wb[e] += 1; } }
        s1v = (F.lane == i) ? s1 : s1v; s2v = (F.lane == i) ? s2 : s2v; }
    if (F.lane < 16) { const int tok = tok0 + F.lane; slot_tok[s1v] = tok; slot_tok[s2v] = tok; tok_slot[2 * tok] = s1v; tok_slot[2 * tok + 1] = s2v; }
}

__device__ __forceinline__ void sub_barrier(unsigned* ctr, unsigned target, bool leader) {
    VM_WAIT(); __syncthreads();
    if (leader) { __builtin_amdgcn_fence(__ATOMIC_RELEASE, "agent"); asm volatile("s_waitcnt vmcnt(0)" ::: "memory");
        __hip_atomic_fetch_add(ctr, 1u, __ATOMIC_RELAXED, __HIP_MEMORY_SCOPE_AGENT);
        unsigned sp = 0; while (__hip_atomic_load(ctr, __ATOMIC_RELAXED, __HIP_MEMORY_SCOPE_AGENT) < target) { __builtin_amdgcn_s_sleep(1); if (++sp > (1u << 20)) break; }
        __builtin_amdgcn_fence(__ATOMIC_ACQUIRE, "agent"); asm volatile("s_waitcnt vmcnt(0)" ::: "memory"); }
    __syncthreads();
}
__device__ __forceinline__ void signal_counter(unsigned* ctr, bool leader) {
    VM_WAIT(); __syncthreads();
    if (leader) { __builtin_amdgcn_fence(__ATOMIC_RELEASE, "agent"); asm volatile("s_waitcnt vmcnt(0)" ::: "memory"); __hip_atomic_fetch_add(ctr, 1u, __ATOMIC_RELAXED, __HIP_MEMORY_SCOPE_AGENT); }
}
__device__ __forceinline__ void wait_counter(unsigned* ctr, unsigned target, bool leader) {
    if (leader) { unsigned sp = 0; while (__hip_atomic_load(ctr, __ATOMIC_RELAXED, __HIP_MEMORY_SCOPE_AGENT) < target) { __builtin_amdgcn_s_sleep(1); if (++sp > (1u << 20)) break; }
        __builtin_amdgcn_fence(__ATOMIC_ACQUIRE, "agent"); asm volatile("s_waitcnt vmcnt(0)" ::: "memory"); }
    __syncthreads();
}
__device__ __forceinline__ void ctx_rows(const Frame& F, int l, int sub, const float* xctx, const bf16* fbr, float* octx, bf16* hxc, int hl, int sb, int nsb) {
    const float* modf = (const float*)(F.ws + WS_MODF); const int gidx = sub ? 5 : 2, shidx = sub ? 0 : 3, r = 8;
    RowVecs V;
#pragma unroll
    for (int j = 0; j < 4; ++j) { const int c = 4 * F.lane + 256 * j;
        V.gate[j] = *(const f32x4*)(modf + (l * 9 + r) * 6144 + gidx * 1024 + c);
        V.lng[j] = *(const f32x4*)(F.in(IN_LNG) + (l * 2 + sub) * 1024 + c); V.lnb[j] = *(const f32x4*)(F.in(IN_LNB) + (l * 2 + sub) * 1024 + c);
        V.sh[j] = *(const f32x4*)(modf + (hl * 9 + r) * 6144 + shidx * 1024 + c); V.sc[j] = *(const f32x4*)(modf + (hl * 9 + r) * 6144 + (shidx + 1) * 1024 + c); }
#pragma unroll 1
    for (int cr = sb * NWAVES + F.wave; cr < M_CTX; cr += nsb * NWAVES) {
        const RowIn RC = row_load<true, 0>(F, xctx + (size_t)cr * DM, fbr + (size_t)cr * DM, 0);
        row_one<true, true, true, true, 0>(F, V, RC, octx + (size_t)cr * DM, hxc + (size_t)cr * DM, 0, (const LAS float*)F.lds); }
}
__device__ __forceinline__ void ctx_rows4(const Frame& F, int l, int sub, const float* xctx, const bf16* f0, const bf16* f1, const bf16* f2, const bf16* f3, float* octx, bf16* hxc, int hl, int sb, int nsb) {
    const float* modf = (const float*)(F.ws + WS_MODF); const int gidx = sub ? 5 : 2, shidx = sub ? 0 : 3, r = 8;
    RowVecs V;
#pragma unroll
    for (int j = 0; j < 4; ++j) { const int c = 4 * F.lane + 256 * j;
        V.gate[j] = *(const f32x4*)(modf + (l * 9 + r) * 6144 + gidx * 1024 + c);
        V.lng[j] = *(const f32x4*)(F.in(IN_LNG) + (l * 2 + sub) * 1024 + c); V.lnb[j] = *(const f32x4*)(F.in(IN_LNB) + (l * 2 + sub) * 1024 + c);
        V.sh[j] = *(const f32x4*)(modf + (hl * 9 + r) * 6144 + shidx * 1024 + c); V.sc[j] = *(const f32x4*)(modf + (hl * 9 + r) * 6144 + (shidx + 1) * 1024 + c); }
#pragma unroll 1
    for (int cr = sb * NWAVES + F.wave; cr < M_CTX; cr += nsb * NWAVES) {
        RowIn RC; const GAS f32x4* xr = (const GAS f32x4*)(xctx + (size_t)cr * DM) + F.lane; const size_t fo = (size_t)cr * DM;
#pragma unroll
        for (int j = 0; j < 4; ++j) { const v2u a = ((const GAS v2u*)(f0 + fo) + F.lane)[64 * j], b2 = ((const GAS v2u*)(f1 + fo) + F.lane)[64 * j], c = ((const GAS v2u*)(f2 + fo) + F.lane)[64 * j], d = ((const GAS v2u*)(f3 + fo) + F.lane)[64 * j];
            const f32x4 f = ((f32x4){bf_lo(a.x), bf_hi(a.x), bf_lo(a.y), bf_hi(a.y)} + (f32x4){bf_lo(b2.x), bf_hi(b2.x), bf_lo(b2.y), bf_hi(b2.y)}) + ((f32x4){bf_lo(c.x), bf_hi(c.x), bf_lo(c.y), bf_hi(c.y)} + (f32x4){bf_lo(d.x), bf_hi(d.x), bf_lo(d.y), bf_hi(d.y)});
            RC.v[j] = xr[64 * j] * DN_ALPHA + V.gate[j] * f; }
        row_one<false, true, true, true, 0>(F, V, RC, octx + (size_t)cr * DM, hxc + (size_t)cr * DM, 0, (const LAS float*)F.lds); }
}
template <int PART>
__device__ __forceinline__ void ctx_pipeline(const Frame& F);
typedef short s16x4 __attribute__((ext_vector_type(4)));
typedef short bf16x8 __attribute__((ext_vector_type(8)));
typedef float f32x16 __attribute__((ext_vector_type(16)));
__device__ __forceinline__ unsigned off_b(unsigned row, unsigned ch) { return 256u * row + 16u * (ch ^ (((row & 3u) << 2) | ((row >> 2) & 3u))); }
__device__ __forceinline__ bf16x8 frag_row(LAS unsigned char* img, int row0, int s, int lane, int cb0 = 0) { return *(const LAS bf16x8*)(img + off_b(row0 + (lane & 31), cb0 + 2 * s + (lane >> 5))); }
__device__ __forceinline__ bf16x8 frag_tr(LAS unsigned char* img, int c, int ks, int lane) {
    const unsigned h = lane >> 5, blk = (lane >> 4) & 1, q = (lane & 15) >> 2, p = lane & 3;
    const unsigned a0 = off_b(16 * ks + 8 * h + q, 4 * c + 2 * blk + (p >> 1)) + 8 * (p & 1), a1 = off_b(16 * ks + 8 * h + 4 + q, 4 * c + 2 * blk + (p >> 1)) + 8 * (p & 1);
    const s16x4 lo = __builtin_amdgcn_ds_read_tr16_b64_v4i16((LAS s16x4*)(img + a0)), hi = __builtin_amdgcn_ds_read_tr16_b64_v4i16((LAS s16x4*)(img + a1));
    return __builtin_shufflevector(lo, hi, 0, 1, 2, 3, 4, 5, 6, 7);
}
#ifdef PROBE_NO_MFMA
#define MFMA32(a, b, c) (c)
#else
#ifdef PROBE_NO_MFMA
#define MFMA32(a, b, c) (c)
#else
#define MFMA32(a, b, c) __builtin_amdgcn_mfma_f32_32x32x16_bf16((a), (b), (c), 0, 0, 0)
#endif
#define LDS_BAR() do { asm volatile("s_waitcnt lgkmcnt(0)" ::: "memory"); __builtin_amdgcn_s_barrier(); asm volatile("" ::: "memory"); } while (0)
#define SEXP(x) __expf(x)
#endif
#define LDS_BAR() do { asm volatile("s_waitcnt lgkmcnt(0)" ::: "memory"); __builtin_amdgcn_s_barrier(); asm volatile("" ::: "memory"); } while (0)
#ifdef PROBE_NO_EXP
#define SEXP(x) ((x) * 0.5f + 1.0f)
#else
#define SEXP(x) __expf(x)
#endif
__device__ __forceinline__ f32x16 zero16() { f32x16 z; for (int i = 0; i < 16; ++i) z[i] = 0.f; return z; }
__device__ __forceinline__ void store_tile_T(LAS unsigned char* img, int col0, int rowchunk0, const f32x16& t, int lane) {
    const int c = col0 + (lane & 31), h = lane >> 5;
#pragma unroll
    for (int g = 0; g < 4; ++g) { v2u w; w.x = pk2(t[4 * g], t[4 * g + 1]); w.y = pk2(t[4 * g + 2], t[4 * g + 3]); *(LAS v2u*)(img + off_b(c, rowchunk0 + g) + 8 * h) = w; }
}
__device__ __forceinline__ unsigned scr_off(int row, int c) { return (unsigned)(row * 64 + (((c + (row >> 2)) & 3) << 4)); }
__device__ __forceinline__ float clamp80(float x) { return fminf(fmaxf(x, -80.f), 80.f); }
__device__ __forceinline__ int crow_of(int b, int dir, int s, int i) { bool ic; int tg; return chain_row(b, dir, s, i, ic, tg); }
__device__ __forceinline__ void ctx_combine(const Frame& F, int b, int ycol0, const float* normw, int zgcol0) {
    const bf16* cf = (const bf16*)(F.ws + WS_CFB); const bf16* cb = cf + (size_t)M_CTX * DM; const bf16* z = (const bf16*)(F.ws + WS_Z); bf16* y = (bf16*)(F.ws + WS_A1);
    const int c4 = (F.tid & 31) * 4; const f32x4 nw = *(const f32x4*)(normw + c4);
#pragma unroll 1
    for (int pass = 0; pass < 16; ++pass) { const int cr = b * CTXL + pass * 16 + (F.tid >> 5); const size_t o = (size_t)cr * DM + ycol0 + c4;
        const v2u a = *(const GAS v2u*)(cf + o), c = *(const GAS v2u*)(cb + o), g = *(const GAS v2u*)(z + (size_t)(M_LAT + cr) * ZLD + zgcol0 + c4);
        const float t0 = bf_lo(a.x) + bf_lo(c.x), t1 = bf_hi(a.x) + bf_hi(c.x), t2 = bf_lo(a.y) + bf_lo(c.y), t3 = bf_hi(a.y) + bf_hi(c.y);
        float ss = t0 * t0 + t1 * t1 + t2 * t2 + t3 * t3;
#pragma unroll
        for (int m = 1; m < 32; m <<= 1) ss += __shfl_xor(ss, m);
        const float rr = 1.0f / sqrtf(ss * (1.f / 128.f) + RMS_EPS);
        v2u w; w.x = pk2(t0 * rr * nw.x * bf_lo(g.x), t1 * rr * nw.y * bf_hi(g.x)); w.y = pk2(t2 * rr * nw.z * bf_lo(g.y), t3 * rr * nw.w * bf_hi(g.y));
        *(GAS v2u*)(y + (size_t)(M_LAT + cr) * DM + ycol0 + c4) = w; }
}

constexpr int HG_QT = 0, HG_QH = 16384, HG_KT = 32768, HG_VT = 49152, HG_AM = 65536, HG_SB = 81920, HG_TOT = 114688, HG_E1 = HG_TOT + 4096, HG_E2 = HG_E1 + 512, HG_SSQ = HG_E2 + 512;
__device__ __forceinline__ void hgrn_scan(const Frame& F, int l, int b, int h, int dir, int half, bool ctx_out) {
    const bf16* z = (const bf16*)(F.ws + WS_Z); bf16* y = (bf16*)(F.ws + WS_A1); bf16* craw = (bf16*)(F.ws + WS_CFB) + (size_t)dir * M_CTX * DM;
    LAS unsigned char* lds = F.lds;
    LAS float* tot = (LAS float*)(lds + HG_TOT); LAS float* e1t = (LAS float*)(lds + HG_E1); LAS float* e2t = (LAS float*)(lds + HG_E2); LAS float* ssq = (LAS float*)(lds + HG_SSQ);
    const int tid = F.tid, lane = F.lane, wv = F.wave, cp = tid & 63, lh = lane >> 5, l31 = lane & 31;
    const int tvo = wv >> 1, ti = wv & 1;
    const int td = wv >> 1, tv0 = 2 * (wv & 1);
    const int ycol0 = h * 128, zq = ZC_HQ + h * 128, zf = (dir ? ZC_HF1 : ZC_HF0) + h * 128, zv = ZC_HI + h * 128, zg = ZC_HG + h * 128;
    float* st = (float*)(F.ws + WS_STATE) + (size_t)F.bid * 32768 + ((size_t)(wv * 2) * 64 + lane) * 16;
    f32x16 S0, S1;
    if (half == 0) { S0 = zero16(); S1 = zero16(); }
    else { for (int q4 = 0; q4 < 4; ++q4) { const f32x4 a = *(const GAS f32x4*)(st + 4 * q4), c = *(const GAS f32x4*)(st + 1024 + 4 * q4); for (int e = 0; e < 4; ++e) { S0[4 * q4 + e] = a[e]; S1[4 * q4 + e] = c[e]; } } }
    store_tile_T(lds + HG_SB, 32 * tv0, 4 * td, S0, lane); store_tile_T(lds + HG_SB, 32 * (tv0 + 1), 4 * td, S1, lane);
    const float* const nwp = F.in(IN_HGNORM) + (l * 4 + h) * 128 + 32 * tvo + 4 * lh;
    if (half == 1) {
        (void)ctx_out;
    }
    const int s_beg = half ? 36 : 0, s_end = half ? 68 : 36;
    unsigned qreg[8], freg[8]; v4u vreg[2];
    const int sgn = dir ? -1 : 1, t0 = dir ? 63 : 0;
    const unsigned voff_qf = 4u * (unsigned)cp;
    const unsigned voff_v = (unsigned)(((dir ? 3 - (lane >> 4) : (lane >> 4)) * ZLD + (tid & 15) * 8) * 2);
#define HG_RB(s_) (((s_) < 4) ? M_LAT + b * CTXL + (dir ? 3 - (s_) : (s_)) * 64 : b * SEQ + (dir ? 67 - (s_) : (s_) - 4) * 64)
#ifdef PROBE_SAME_ROWS
#define HG_RBL(s_) (b * SEQ + ((s_) & 1) * 64)
#else
#define HG_RBL(s_) HG_RB(s_)
#endif
#define HG_LOAD(s_) do { const int rb_ = HG_RBL(s_); \
        _Pragma("unroll") for (int p = 0; p < 8; ++p) { const GAS char* zr = (const GAS char*)(z + (size_t)(rb_ + t0 + sgn * (8 * wv + p)) * ZLD); \
            qreg[p] = *(const GAS unsigned*)(zr + 2 * zq + voff_qf); freg[p] = *(const GAS unsigned*)(zr + 2 * zf + voff_qf); } \
        _Pragma("unroll") for (int k2 = 0; k2 < 2; ++k2) { const GAS char* zr = (const GAS char*)(z + (size_t)(rb_ + t0 + sgn * (4 * wv + 32 * k2) - (dir ? 3 : 0)) * ZLD + zv); \
            vreg[k2] = *(const GAS v4u*)(zr + voff_v); } } while (0)
    HG_LOAD(s_beg);
    LDS_BAR();
#ifdef PROBE_SEC
    unsigned long long sec_acc = 0, sec_t0 = 0;
#define SEC(k) do { const unsigned long long t_ = __builtin_amdgcn_s_memtime(); if ((k) == PROBE_SEC) sec_t0 = t_; if ((k) == PROBE_SEC + 1 || (PROBE_SEC == 4 && (k) == 0 && sec_t0 != 0)) sec_acc += t_ - sec_t0; } while (0)
#else
#define SEC(k) do {} while (0)
#endif
#pragma unroll 1
    for (int s = s_beg; s < s_end; ++s) {
        SEC(0);
        f32x2 gl[8]; f32x2 run = {0.f, 0.f};
#pragma unroll
        for (int p = 0; p < 8; ++p) { run += (f32x2){bf_lo(freg[p]), bf_hi(freg[p])}; gl[p] = run; }
        *(LAS f32x2*)(tot + wv * 128 + 2 * cp) = run;
#pragma unroll
        for (int k2 = 0; k2 < 2; ++k2) { const int idx = tid + 512 * k2; *(LAS v4u*)(lds + HG_VT + off_b(idx >> 4, idx & 15)) = vreg[k2]; }
        LDS_BAR();
        SEC(1);
        f32x2 pre = {0.f, 0.f}, gr = {0.f, 0.f};
#pragma unroll
        for (int w2 = 0; w2 < 4; ++w2) { const f32x2 t2 = *(const LAS f32x2*)(tot + w2 * 128 + 2 * cp); gr += t2; if (w2 < wv) pre += t2; }
#pragma unroll
        for (int w2 = 4; w2 < 7; ++w2) { if (w2 < wv) pre += *(const LAS f32x2*)(tot + w2 * 128 + 2 * cp); }
        const f32x2 egr = {__builtin_amdgcn_exp2f(gr.x), __builtin_amdgcn_exp2f(gr.y)};
        if (wv == 0) { f32x2 gt2 = {0.f, 0.f};
#pragma unroll
            for (int w2 = 4; w2 < 8; ++w2) gt2 += *(const LAS f32x2*)(tot + w2 * 128 + 2 * cp);
            *(LAS f32x2*)(e1t + 2 * cp) = egr; *(LAS f32x2*)(e2t + 2 * cp) = (f32x2){__builtin_amdgcn_exp2f(gt2.x), __builtin_amdgcn_exp2f(gt2.y)}; }
        pre -= gr;
        const unsigned xw = (unsigned)(2 * wv);
#pragma unroll
        for (int p = 0; p < 8; ++p) { const f32x2 d = pre + gl[p];
            const f32x2 E1 = {__builtin_amdgcn_exp2f(__builtin_amdgcn_fmed3f(d.x, -115.f, 115.f)), __builtin_amdgcn_exp2f(__builtin_amdgcn_fmed3f(d.y, -115.f, 115.f))};
            const f32x2 R1 = {__builtin_amdgcn_rcpf(E1.x), __builtin_amdgcn_rcpf(E1.y)};
            const f32x2 kk = (f32x2){1.0f, 1.0f} - (f32x2){__builtin_amdgcn_exp2f(bf_lo(freg[p])), __builtin_amdgcn_exp2f(bf_hi(freg[p]))};
            const f32x2 qt = (f32x2){bf_lo(qreg[p]), bf_hi(qreg[p])} * E1, qh = qt * egr, kt = kk * R1;
            const unsigned xr = (((unsigned)p & 3u) << 2) | ((xw + ((unsigned)p >> 2)) & 3u);
            const unsigned o = 256u * (unsigned)(8 * wv + p) + 16u * (((unsigned)cp >> 2) ^ xr) + ((unsigned)cp & 3u) * 4u;
            *(LAS unsigned*)(lds + HG_QT + o) = pk2(qt.x, qt.y);
            *(LAS unsigned*)(lds + HG_QH + o) = pk2(qh.x, qh.y);
            *(LAS unsigned*)(lds + HG_KT + o) = pk2(kt.x, kt.y); }
#ifndef PROBE_NO_LOAD
        if (half == 0 && s + 1 == 4 + 4 * IP_K(l)) wait_counter((unsigned*)(F.ws + WS_CTL) + CW_IP2 + 64 * l, 128u, tid == 0);
        if (s + 1 < s_end) HG_LOAD(s + 1);
#endif
        const bool octx = s < 4;
        int orow2[2];
#pragma unroll
        for (int rep = 0; rep < 2; ++rep) orow2[rep] = HG_RB(s) + t0 + sgn * (32 * ti + 16 * rep) + sgn * (lane >> 2);
        v4u rov[2], gtv[2];
        if (half == 1) {
#pragma unroll
            for (int rep = 0; rep < 2; ++rep) { rov[rep] = *(const GAS v4u*)(y + (size_t)orow2[rep] * DM + ycol0 + 32 * tvo + 8 * (lane & 3)); gtv[rep] = *(const GAS v4u*)(z + (size_t)orow2[rep] * ZLD + zg + 32 * tvo + 8 * (lane & 3)); }
        }
        LAS unsigned char* const scrA = lds + HG_QT + wv * 2048; LAS unsigned char* const scrB = lds + HG_AM + wv * 2048;
        LDS_BAR();
        SEC(2);
        f32x16 O = zero16();
#pragma unroll
        for (int kb = 0; kb < 2; ++kb) { bf16x8 fa[4], fb[4];
#pragma unroll
          for (int k4 = 0; k4 < 4; ++k4) { fa[k4] = frag_row(lds + HG_SB, 32 * tvo, 4 * kb + k4, lane); fb[k4] = frag_row(lds + HG_QH, 32 * ti, 4 * kb + k4, lane); }
#pragma unroll
          for (int k4 = 0; k4 < 4; ++k4) O = MFMA32(fa[k4], fb[k4], O); }
        if (wv < 3) { const int tj = wv >> 1, tia = (wv + 1) >> 1; f32x16 P = zero16();
#pragma unroll
            for (int kb = 0; kb < 2; ++kb) { bf16x8 fa[4], fb[4];
#pragma unroll
              for (int k4 = 0; k4 < 4; ++k4) { fa[k4] = frag_row(lds + HG_KT, 32 * tj, 4 * kb + k4, lane); fb[k4] = frag_row(lds + HG_QT, 32 * tia, 4 * kb + k4, lane); }
#pragma unroll
              for (int k4 = 0; k4 < 4; ++k4) P = MFMA32(fa[k4], fb[k4], P); }
            const int ii = 32 * tia + l31;
#pragma unroll
            for (int r = 0; r < 16; ++r) { const int jj = 32 * tj + (r & 3) + 8 * (r >> 2) + 4 * lh; if (jj > ii) P[r] = 0.f; }
            store_tile_T(lds + HG_AM, 32 * tia, 4 * tj, P, lane); }
        LDS_BAR();
        SEC(3);
        if (half == 1) {
#pragma unroll
            for (int rep = 0; rep < 2; ++rep) *(LAS v4u*)(scrA + scr_off((lane >> 2) + 16 * rep, lane & 3)) = rov[rep]; }
        { f32x4 e1v[4], e2v[4];
#pragma unroll
          for (int g = 0; g < 4; ++g) { e1v[g] = *(const LAS f32x4*)(e1t + 32 * td + 8 * g + 4 * lh); e2v[g] = *(const LAS f32x4*)(e2t + 32 * td + 8 * g + 4 * lh); }
#pragma unroll
          for (int r = 0; r < 16; ++r) { S0[r] *= e1v[r >> 2][r & 3]; S1[r] *= e1v[r >> 2][r & 3]; }
          { bf16x8 ka[4], v0[4], v1[4];
#pragma unroll
            for (int ks = 0; ks < 4; ++ks) { ka[ks] = frag_tr(lds + HG_KT, td, ks, lane); v0[ks] = frag_tr(lds + HG_VT, tv0, ks, lane); v1[ks] = frag_tr(lds + HG_VT, tv0 + 1, ks, lane); }
#pragma unroll
            for (int ks = 0; ks < 4; ++ks) { S0 = MFMA32(ka[ks], v0[ks], S0); S1 = MFMA32(ka[ks], v1[ks], S1); } }
#pragma unroll
          for (int r = 0; r < 16; ++r) { S0[r] *= e2v[r >> 2][r & 3]; S1[r] *= e2v[r >> 2][r & 3]; }
          store_tile_T(lds + HG_SB, 32 * tv0, 4 * td, S0, lane); store_tile_T(lds + HG_SB, 32 * (tv0 + 1), 4 * td, S1, lane); }
        { bf16x8 fa[4], fb[4];
#pragma unroll
          for (int ks = 0; ks < 4; ++ks) { fa[ks] = frag_tr(lds + HG_VT, tvo, ks, lane); fb[ks] = frag_row(lds + HG_AM, 32 * ti, ks, lane); }
#pragma unroll
          for (int ks = 0; ks < 4; ++ks) if (ks < 2 || ti == 1) O = MFMA32(fa[ks], fb[ks], O); }
        SEC(4);
        if (half == 0) {
#pragma unroll
            for (int g = 0; g < 4; ++g) { v2u w; w.x = pk2(O[4 * g], O[4 * g + 1]); w.y = pk2(O[4 * g + 2], O[4 * g + 3]); *(LAS v2u*)(scrA + scr_off(l31, g) + 8 * lh) = w; }
#pragma unroll
            for (int rep = 0; rep < 2; ++rep) { const v4u w = *(const LAS v4u*)(scrA + scr_off((lane >> 2) + 16 * rep, lane & 3));
                bf16* dst = octx ? craw + (size_t)(orow2[rep] - M_LAT) * DM : y + (size_t)orow2[rep] * DM;
#ifdef PROBE_NO_STORE
                if (w.x == 0x12345678u)
#endif
                *(GAS v4u*)(dst + ycol0 + 32 * tvo + 8 * (lane & 3)) = w; }
            LDS_BAR();
        } else {
            float ss = 0.f;
#pragma unroll
            for (int g = 0; g < 4; ++g) { const v2u r2 = *(const LAS v2u*)(scrA + scr_off(l31, g) + 8 * lh); O[4 * g] += bf_lo(r2.x); O[4 * g + 1] += bf_hi(r2.x); O[4 * g + 2] += bf_lo(r2.y); O[4 * g + 3] += bf_hi(r2.y); }
#pragma unroll
            for (int r = 0; r < 16; ++r) ss += O[r] * O[r];
            ss += __shfl_xor(ss, 32);
            const int ii2 = 32 * ti + l31;
            if (lh == 0) ssq[tvo * 64 + ii2] = ss;
            LDS_BAR();
#pragma unroll
            for (int rep = 0; rep < 2; ++rep) *(LAS v4u*)(scrB + scr_off((lane >> 2) + 16 * rep, lane & 3)) = gtv[rep];
            const float tss = (ssq[ii2] + ssq[64 + ii2]) + (ssq[128 + ii2] + ssq[192 + ii2]), rr = __builtin_amdgcn_rsqf(tss * (1.f / 128.f) + RMS_EPS);
            v2u yw[4];
#pragma unroll
            for (int g = 0; g < 4; ++g) { const v2u g2 = *(const LAS v2u*)(scrB + scr_off(l31, g) + 8 * lh); const f32x4 nv = *(const f32x4*)(nwp + 8 * g);
                yw[g].x = pk2(O[4 * g] * rr * nv.x * bf_lo(g2.x), O[4 * g + 1] * rr * nv.y * bf_hi(g2.x)); yw[g].y = pk2(O[4 * g + 2] * rr * nv.z * bf_lo(g2.y), O[4 * g + 3] * rr * nv.w * bf_hi(g2.y)); }
#pragma unroll
            for (int g = 0; g < 4; ++g) *(LAS v2u*)(scrB + scr_off(l31, g) + 8 * lh) = yw[g];
#pragma unroll
            for (int rep = 0; rep < 2; ++rep) { const v4u w = *(const LAS v4u*)(scrB + scr_off((lane >> 2) + 16 * rep, lane & 3)); *(GAS v4u*)(y + (size_t)orow2[rep] * DM + ycol0 + 32 * tvo + 8 * (lane & 3)) = w; }
        }
        if (half == 0 && s == 3 && ctx_out) signal_counter((unsigned*)(F.ws + WS_CTL) + CW_CC, tid == 0);
    }
#ifdef PROBE_SEC
    if (F.bid == 0 && tid == 0 && l == 0 && half == 0) ((LAS unsigned long long*)(F.lds + LDSCTL_OFF + 2048))[40] = sec_acc;
#endif
#undef SEC
#undef HG_LOAD
    if (half == 0) { for (int q4 = 0; q4 < 4; ++q4) { *(GAS f32x4*)(st + 4 * q4) = (f32x4){S0[4 * q4], S0[4 * q4 + 1], S0[4 * q4 + 2], S0[4 * q4 + 3]}; *(GAS f32x4*)(st + 1024 + 4 * q4) = (f32x4){S1[4 * q4], S1[4 * q4 + 1], S1[4 * q4 + 2], S1[4 * q4 + 3]}; } }
}

constexpr int ML_T1 = 0, ML_T2 = 16384, ML_VT = 32768, ML_PM = 49152, ML_CB = 65536, ML_TAB = 98304;
__device__ __forceinline__ void mlstm_scan(const Frame& F, int l, int b, int h, int dir, int half, bool ctx_out) {
    const bf16* z = (const bf16*)(F.ws + WS_Z); bf16* y = (bf16*)(F.ws + WS_A1); bf16* craw = (bf16*)(F.ws + WS_CFB) + (size_t)dir * M_CTX * DM; const float* gates = (const float*)(F.ws + WS_GATES);
    LAS unsigned char* lds = F.lds;
    LAS float* const tab0 = (LAS float*)(lds + ML_TAB);
    LAS float* ta = tab0;
    LAS float* trs = ta + 384;   LAS float* tn = ta + 512; LAS float* ssq = ta + 640;   LAS float* tnp = ta + 896;   LAS float* tqp = ta + 1408;
    const int tid = F.tid, lane = F.lane, wv = F.wave, cp = tid & 63, lh = lane >> 5, l31 = lane & 31;
    const int tvo = wv >> 1, ti = wv & 1;
    const int td = wv >> 2, tvc = wv & 3;
    const int ycol0 = 512 + h * 128, zv = ZC_MV + h * 128, zg = ZC_MO + h * 128;
    const bool isq = cp < 32; const int c2 = 2 * cp;
    const int chan = isq ? h * 64 + c2 : 256 + h * 64 + (c2 - 64), zqk = ZC_MQ + chan;
    const float* cw = F.in(IN_CONVW) + l * 1536 + chan; const float* cbp = F.in(IN_CONVB) + l * 512 + chan;
    const f32x2 w0 = *(const f32x2*)cw, w1 = *(const f32x2*)(cw + 512), w2 = *(const f32x2*)(cw + 1024), cbias = *(const f32x2*)cbp;
    float* st = (float*)(F.ws + WS_STATE) + (size_t)F.bid * 32768;
    f32x16 C; float mprev = 0.f;
    if (half == 0) { C = zero16(); if (tid < 64) { tn[tid] = 0.f; } }
    else { const float* sp = st + ((size_t)wv * 64 + lane) * 16;
        for (int q4 = 0; q4 < 4; ++q4) { const f32x4 a = *(const GAS f32x4*)(sp + 4 * q4); for (int e = 0; e < 4; ++e) C[4 * q4 + e] = a[e]; }
        if (tid < 64) tn[tid] = st[8192 + tid];
        mprev = st[8192 + 64]; }
    if (tid < 128) trs[tid] = 0.f;
    store_tile_T(lds + ML_CB, 32 * tvc, 4 * td, C, lane);
    const float* const nwp = F.in(IN_MLNORM) + (l * 4 + h) * 128 + 32 * tvo + 4 * lh;
    if (half == 1) {
        (void)ctx_out;
    }
    const int s_beg = half ? 36 : 0, s_end = half ? 68 : 36;
    unsigned ureg[10]; v4u vreg[2]; float gli = 0.f, glf = 0.f;
#define ML_LOAD(s_) do { const int s__ = (s_); const bool cx = s__ < 4; const int chk = cx ? (dir ? 3 - s__ : s__) : (dir ? 67 - s__ : s__ - 4); \
        const int rb = cx ? M_LAT + b * CTXL + chk * 64 : b * SEQ + chk * 64; const int tlo = dir ? 56 - 8 * wv : 8 * wv; \
        _Pragma("unroll") for (int m = 0; m < 10; ++m) { const int t = tlo - 1 + m; const int tg = cx ? chk * 64 + t : t; const bool ok = cx ? (tg >= 0 && tg < CTXL) : (t >= 0 && t < 64); \
            ureg[m] = ok ? *(const GAS unsigned*)(z + (size_t)(rb + t) * ZLD + zqk) : 0u; } \
        _Pragma("unroll") for (int k2 = 0; k2 < 2; ++k2) { const GAS char* zr_ = (const GAS char*)(z + (size_t)(rb + (dir ? 63 : 0) + (dir ? -1 : 1) * (4 * wv + 32 * k2) - (dir ? 3 : 0)) * ZLD + zv); \
            vreg[k2] = *(const GAS v4u*)(zr_ + (unsigned)(((dir ? 3 - (lane >> 4) : (lane >> 4)) * ZLD + (tid & 15) * 8) * 2)); } \
        if (wv == 7) { const float* gp = gates + (size_t)crow_of(b, dir, s__, lane) * 16 + dir * 8 + h; gli = gp[0]; glf = gp[4]; } } while (0)
#define ML_GATES(s_) do { LAS float* tg_ = tab0 + ((s_) & 1) * 1920; float bb = wave_scan_add(glf); \
        const float aa = gli - bb; float am = wave_scan_max(aa); \
        const float mu = fmaxf(am, mprev), mu63 = __builtin_bit_cast(float, __builtin_amdgcn_readlane(__builtin_bit_cast(int, mu), 63)), b63 = __builtin_bit_cast(float, __builtin_amdgcn_readlane(__builtin_bit_cast(int, bb), 63)); \
        tg_[lane] = aa; tg_[64 + lane] = mu; tg_[128 + lane] = __expf(aa - mu63); tg_[192 + lane] = __expf(mprev - mu); tg_[256 + lane] = __expf(fminf(-(bb + mu), 80.f)); \
        if (lane == 0) tg_[320] = __expf(mprev - mu63); \
        mprev = b63 + mu63; } while (0)
    ML_LOAD(s_beg);
    if (wv == 7) ML_GATES(s_beg);
    LDS_BAR();
#ifdef PROBE_MSEC
    unsigned long long msec_acc = 0, msec_t0 = 0;
#define MSEC(k) do { const unsigned long long t_ = __builtin_amdgcn_s_memtime(); if ((k) == PROBE_MSEC) msec_t0 = t_; if ((k) == PROBE_MSEC + 1 || (PROBE_MSEC == 4 && (k) == 0 && msec_t0 != 0)) msec_acc += t_ - msec_t0; } while (0)
#else
#define MSEC(k) do {} while (0)
#endif
#pragma unroll 1
    for (int s = s_beg; s < s_end; ++s) {
        MSEC(0);
        ta = tab0 + (s & 1) * 1920; LAS float* const tmu = ta + 64; LAS float* const twk = ta + 128; LAS float* const twi = ta + 192; LAS float* const temi = ta + 256; LAS float* const tsc = ta + 320;
        float kv0[8], kv1[8];
#pragma unroll
        for (int p = 0; p < 8; ++p) { const int i = 8 * wv + p; const unsigned up = dir ? ureg[7 - p] : ureg[p], uc = dir ? ureg[8 - p] : ureg[p + 1], un = dir ? ureg[9 - p] : ureg[p + 2];
            const float c0 = cbias.x + w0.x * bf_lo(up) + w1.x * bf_lo(uc) + w2.x * bf_lo(un), c1 = cbias.y + w0.y * bf_hi(up) + w1.y * bf_hi(uc) + w2.y * bf_hi(un);
            float s0 = c0 * __builtin_amdgcn_rcpf(1.0f + __builtin_amdgcn_exp2f(-1.44269504f * c0)), s1 = c1 * __builtin_amdgcn_rcpf(1.0f + __builtin_amdgcn_exp2f(-1.44269504f * c1));
            if (isq) { s0 *= 0.125f; s1 *= 0.125f; }
            kv0[p] = s0; kv1[p] = s1;
            *(LAS unsigned*)(lds + ML_T1 + off_b(i, cp >> 2) + (cp & 3) * 4) = pk2(s0, s1); }
#pragma unroll
        for (int k2 = 0; k2 < 2; ++k2) { const int idx = tid + 512 * k2; *(LAS v4u*)(lds + ML_VT + off_b(idx >> 4, idx & 15)) = vreg[k2]; }
        if (half == 0 && s + 1 == 4 + 4 * IP_K(l)) wait_counter((unsigned*)(F.ws + WS_CTL) + CW_IP2 + 64 * l, 128u, tid == 0);
        if (s + 1 < s_end) ML_LOAD(s + 1);
        const int orow = crow_of(b, dir, s, 32 * ti + l31); const bool octx = s < 4;
        int orow2[2];
#pragma unroll
        for (int rep = 0; rep < 2; ++rep) orow2[rep] = crow_of(b, dir, s, 32 * ti + (lane >> 2) + 16 * rep);
        v4u rov[2], gtv[2];
        if (half == 1) {
#pragma unroll
            for (int rep = 0; rep < 2; ++rep) { rov[rep] = *(const GAS v4u*)(y + (size_t)orow2[rep] * DM + ycol0 + 32 * tvo + 8 * (lane & 3)); gtv[rep] = *(const GAS v4u*)(z + (size_t)orow2[rep] * ZLD + zg + 32 * tvo + 8 * (lane & 3)); }
        }
        LAS unsigned char* const scrA = lds + ML_T1 + wv * 2048; LAS unsigned char* const scrB = lds + ML_PM + wv * 2048;
        LDS_BAR();
        MSEC(1);
        if (!isq) {
            float ps0 = 0.f, ps1 = 0.f;
#pragma unroll
            for (int p = 0; p < 8; ++p) { const int i = 8 * wv + p; const float wk = twk[i]; const unsigned pk = pk2(kv0[p] * wk, kv1[p] * wk); ps0 += bf_lo(pk); ps1 += bf_hi(pk);
                *(LAS unsigned*)(lds + ML_T2 + off_b(i, (cp - 32) >> 2) + (cp & 3) * 4) = pk; }
            *(LAS f32x2*)(tnp + wv * 64 + (c2 - 64)) = (f32x2){ps0, ps1};
        }
        {
            const v4u qv = *(const LAS v4u*)(lds + ML_T1 + off_b(lane, wv)); const f32x4 n0 = *(const LAS f32x4*)(tn + 8 * wv), n1 = *(const LAS f32x4*)(tn + 8 * wv + 4);
            tqp[wv * 64 + lane] = bf_lo(qv.x) * n0.x + bf_hi(qv.x) * n0.y + bf_lo(qv.y) * n0.z + bf_hi(qv.y) * n0.w + bf_lo(qv.z) * n1.x + bf_hi(qv.z) * n1.y + bf_lo(qv.w) * n1.z + bf_hi(qv.w) * n1.w;
        }
        LDS_BAR();
        MSEC(2);
        if (wv == 7 && s + 1 < s_end) ML_GATES(s + 1);
        const int ii = 32 * ti + l31;
        f32x16 H = zero16();
        { bf16x8 fa[4], fb[4];
#pragma unroll
          for (int k4 = 0; k4 < 4; ++k4) { fa[k4] = frag_row(lds + ML_CB, 32 * tvo, k4, lane); fb[k4] = frag_row(lds + ML_T1, 32 * ti, k4, lane); }
#pragma unroll
          for (int k4 = 0; k4 < 4; ++k4) H = MFMA32(fa[k4], fb[k4], H); }
        { const float wi = twi[ii];
#pragma unroll
          for (int r = 0; r < 16; ++r) H[r] *= wi; }
        if (wv < 3) { const int tj = wv >> 1, tia = (wv + 1) >> 1; f32x16 P = zero16();
            { bf16x8 fa[4], fb[4];
#pragma unroll
              for (int k4 = 0; k4 < 4; ++k4) { fa[k4] = frag_row(lds + ML_T1, 32 * tj, k4, lane, 8); fb[k4] = frag_row(lds + ML_T1, 32 * tia, k4, lane); }
#pragma unroll
              for (int k4 = 0; k4 < 4; ++k4) P = MFMA32(fa[k4], fb[k4], P); }
            const int ia = 32 * tia + l31; const float mui = tmu[ia]; float rs = 0.f;
#pragma unroll
            for (int g = 0; g < 4; ++g) { const f32x4 av = *(const LAS f32x4*)(ta + 32 * tj + 8 * g + 4 * lh);
#pragma unroll
                for (int e = 0; e < 4; ++e) { const int r = 4 * g + e, jj = 32 * tj + 8 * g + 4 * lh + e; const float pv = (jj > ia) ? 0.f : P[r] * __expf(av[e] - mui); P[r] = pv; rs += pv; } }
            rs += __shfl_xor(rs, 32);
            if (lh == 0) trs[tj * 64 + ia] = rs;
            store_tile_T(lds + ML_PM, 32 * tia, 4 * tj, P, lane); }
        LDS_BAR();
        MSEC(3);
        if (half == 1) {
#pragma unroll
            for (int rep = 0; rep < 2; ++rep) *(LAS v4u*)(scrA + scr_off((lane >> 2) + 16 * rep, lane & 3)) = rov[rep]; }
        { const float dec = tsc[0];
#pragma unroll
          for (int r = 0; r < 16; ++r) C[r] *= dec;
          { bf16x8 fa[4], fb[4];
#pragma unroll
            for (int ks = 0; ks < 4; ++ks) { fa[ks] = frag_tr(lds + ML_T2, td, ks, lane); fb[ks] = frag_tr(lds + ML_VT, tvc, ks, lane); }
#pragma unroll
            for (int ks = 0; ks < 4; ++ks) C = MFMA32(fa[ks], fb[ks], C); }
          store_tile_T(lds + ML_CB, 32 * tvc, 4 * td, C, lane);
          if (tid < 64) {
              float acc = 0.f;
#pragma unroll
              for (int w2 = 0; w2 < 8; ++w2) acc += tnp[w2 * 64 + tid];
              tn[tid] = dec * tn[tid] + acc; } }
        { bf16x8 fa[4], fb[4];
#pragma unroll
          for (int ks = 0; ks < 4; ++ks) { fa[ks] = frag_tr(lds + ML_VT, tvo, ks, lane); fb[ks] = frag_row(lds + ML_PM, 32 * ti, ks, lane); }
#pragma unroll
          for (int ks = 0; ks < 4; ++ks) if (ks < 2 || ti == 1) H = MFMA32(fa[ks], fb[ks], H); }
        { float qn = 0.f;
#pragma unroll
          for (int w2 = 0; w2 < 8; ++w2) qn += tqp[w2 * 64 + ii];
          const float den = trs[ii] + trs[64 + ii] + twi[ii] * qn, sc = __builtin_amdgcn_rcpf(fmaxf(fabsf(den), temi[ii]));
#pragma unroll
          for (int r = 0; r < 16; ++r) H[r] *= sc; }
        MSEC(4);
        if (half == 0) {
#pragma unroll
            for (int g = 0; g < 4; ++g) { v2u w; w.x = pk2(H[4 * g], H[4 * g + 1]); w.y = pk2(H[4 * g + 2], H[4 * g + 3]); *(LAS v2u*)(scrA + scr_off(l31, g) + 8 * lh) = w; }
#pragma unroll
            for (int rep = 0; rep < 2; ++rep) { const v4u w = *(const LAS v4u*)(scrA + scr_off((lane >> 2) + 16 * rep, lane & 3));
                bf16* dst = octx ? craw + (size_t)(orow2[rep] - M_LAT) * DM : y + (size_t)orow2[rep] * DM; *(GAS v4u*)(dst + ycol0 + 32 * tvo + 8 * (lane & 3)) = w; }
            LDS_BAR();
        } else {
            float ss = 0.f;
#pragma unroll
            for (int g = 0; g < 4; ++g) { const v2u r2 = *(const LAS v2u*)(scrA + scr_off(l31, g) + 8 * lh); H[4 * g] += bf_lo(r2.x); H[4 * g + 1] += bf_hi(r2.x); H[4 * g + 2] += bf_lo(r2.y); H[4 * g + 3] += bf_hi(r2.y); }
#pragma unroll
            for (int r = 0; r < 16; ++r) ss += H[r] * H[r];
            ss += __shfl_xor(ss, 32);
            const int ii2 = 32 * ti + l31;
            if (lh == 0) ssq[tvo * 64 + ii2] = ss;
            LDS_BAR();
#pragma unroll
            for (int rep = 0; rep < 2; ++rep) *(LAS v4u*)(scrB + scr_off((lane >> 2) + 16 * rep, lane & 3)) = gtv[rep];
            const float tss = (ssq[ii2] + ssq[64 + ii2]) + (ssq[128 + ii2] + ssq[192 + ii2]), rr = __builtin_amdgcn_rsqf(tss * (1.f / 128.f) + RMS_EPS);
            v2u yw[4];
#pragma unroll
            for (int g = 0; g < 4; ++g) { const v2u g2 = *(const LAS v2u*)(scrB + scr_off(l31, g) + 8 * lh); const f32x4 nv = *(const f32x4*)(nwp + 8 * g);
                yw[g].x = pk2(H[4 * g] * rr * nv.x * bf_lo(g2.x), H[4 * g + 1] * rr * nv.y * bf_hi(g2.x)); yw[g].y = pk2(H[4 * g + 2] * rr * nv.z * bf_lo(g2.y), H[4 * g + 3] * rr * nv.w * bf_hi(g2.y)); }
#pragma unroll
            for (int g = 0; g < 4; ++g) *(LAS v2u*)(scrB + scr_off(l31, g) + 8 * lh) = yw[g];
#pragma unroll
            for (int rep = 0; rep < 2; ++rep) { const v4u w = *(const LAS v4u*)(scrB + scr_off((lane >> 2) + 16 * rep, lane & 3)); *(GAS v4u*)(y + (size_t)orow2[rep] * DM + ycol0 + 32 * tvo + 8 * (lane & 3)) = w; }
        }
        if (half == 0 && s == 3 && ctx_out) signal_counter((unsigned*)(F.ws + WS_CTL) + CW_CC, tid == 0);
    }
#ifdef PROBE_MSEC
    if (F.bid == 64 && tid == 0 && l == 0 && half == 0) ((LAS unsigned long long*)(F.lds + LDSCTL_OFF + 2048))[41] = msec_acc;
#endif
#undef MSEC
#undef ML_GATES
#undef ML_LOAD
    if (half == 0) { float* sp = st + ((size_t)wv * 64 + lane) * 16;
        for (int q4 = 0; q4 < 4; ++q4) *(GAS f32x4*)(sp + 4 * q4) = (f32x4){C[4 * q4], C[4 * q4 + 1], C[4 * q4 + 2], C[4 * q4 + 3]};
        __syncthreads();
        if (tid < 64) st[8192 + tid] = tn[tid];
        if (tid == 448) st[8192 + 64] = mprev; }
}

template <int PART>
__device__ __forceinline__ void ctx_pipeline(const Frame& F) {
    unsigned char* ws = F.ws; unsigned* ctl = (unsigned*)(ws + WS_CTL); const bool leader = F.tid == 0; const int sb = F.bid - 128, NS = F.G - 128;
    bf16* const A1c = (bf16*)(ws + WS_A1) + (size_t)M_LAT * DM; bf16* const FC = (bf16*)(ws + WS_FC); bf16* const HC = (bf16*)(ws + WS_HC); bf16* const F2C = (bf16*)(ws + WS_F2C);
    float* const XC = (float*)(ws + WS_XC);
    XcdBarrier sbar; sbar.bar = ctl + CW_BAR2; sbar.x = xb_xcc_id(); sbar.st = (volatile LAS unsigned*)(F.lds + MISC_OFF) + 10; sbar.members = (unsigned)NS;
#define SUB_BAR() xcd_barrier(sbar, leader)
    if (PART == 0) {
        if (leader) (void)xb_add(&sbar.bar[XB_XCNT(sbar.x)], 1u);
        wait_counter(ctl + CW_CC, 128u, leader);
        if (sb < 64) { const int type = sb >> 5, b = (sb >> 2) & 7, h = sb & 3;
            ctx_combine(F, b, type * 512 + h * 128, (type ? F.in(IN_MLNORM) : F.in(IN_HGNORM)) + h * 128, (type ? ZC_MO : ZC_HG) + h * 128); }
        SUB_BAR();
        { pg8::Gemm g{A1c, (const bf16*)(ws + WS_WOUT0), M_CTX, DM, DM}; pg8::StaticOrder S; S.init(M_CTX, DM, NS, sb); pg8::EpiPlain E{FC, DM, 1024};
          pg8::gemm_phase<pg8::EpiPlain, pg8::StaticOrder, true, true>(F.lds, g, S, E, F.tid); }
        SUB_BAR();
        ctx_rows(F, 0, 0, F.in(IN_CTX), FC, XC, A1c, 0, sb, NS);
    } else {
        { pg8::Gemm g{A1c, (const bf16*)(ws + WS_FGU), M_CTX, 2 * DFF, DM}; pg8::StaticOrder S; S.init(M_CTX, 2 * DFF, NS, sb); pg8::EpiSwiGLU E{HC, DFF, 1024, 0};
          pg8::gemm_phase<pg8::EpiSwiGLU, pg8::StaticOrder, true, true>(F.lds, g, S, E, F.tid); }
        SUB_BAR();
        { pg8::Gemm g{HC, (const bf16*)(ws + WS_FDN), M_CTX, DM, DFF}; pg8::StaticOrder S; S.init(M_CTX, DM, NS, sb); pg8::EpiPlain E{F2C, DM, 1024};
          pg8::gemm_phase<pg8::EpiPlain, pg8::StaticOrder, true, true>(F.lds, g, S, E, F.tid); }
        SUB_BAR();
        ctx_rows(F, 0, 1, XC, F2C, XC, A1c, 1, sb, NS);
        SUB_BAR();
        { gates_mfma(F, 1, 128, NS, M_LAT / 16, M_ALL / 16);
          pg8::Gemm g{A1c, (const bf16*)(ws + WS_WIN1), M_CTX, ZLD, DM}; pg8::StaticOrder S; S.init(M_CTX, ZLD, NS, sb); pg8::EpiZ E{(bf16*)(ws + WS_Z) + (size_t)M_LAT * ZLD, (const float*)(ws + WS_LBV) + 1024};
          pg8::gemm_phase<pg8::EpiZ, pg8::StaticOrder, true, true>(F.lds, g, S, E, F.tid); }
    }
#undef SUB_BAR
}
#ifndef EN_MASK
#define EN_MASK 0xffff
#endif
#define EN(c) (((EN_MASK) >> (c)) & 1)
__global__ void __launch_bounds__(NTHREADS, 2) hyb_fwd(Args args) {
    extern __shared__ __attribute__((aligned(16))) unsigned char lds_raw[];
    Frame F0;
    F0.lds = (LAS unsigned char*)lds_raw;
    F0.tid = threadIdx.x; F0.lane = F0.tid & 63; F0.wave = __builtin_amdgcn_readfirstlane(F0.tid >> 6);
    F0.bid = blockIdx.x; F0.G = gridDim.x; F0.ws = args.ws;
    volatile LAS unsigned* MISC = (volatile LAS unsigned*)(F0.lds + MISC_OFF);
    for (int u = F0.tid; u < (LDS_BYTES - LDSCTL_OFF) / 4; u += NTHREADS) ((LAS unsigned*)(F0.lds + LDSCTL_OFF))[u] = 0u;
    if (F0.tid == 0) { LAS unsigned long long* tab = (LAS unsigned long long*)(F0.lds + PTAB_OFF);
#pragma unroll
        for (int i = 0; i < 22; ++i) tab[i] = (unsigned long long)args.in[i];
        tab[22] = (unsigned long long)args.out; }
    __syncthreads();
    const bool single = args.single != 0;
    XcdBarrier bar; bar.bar = (unsigned*)(args.ws + WS_CTL) + CW_BAR; bar.x = 0; bar.st = nullptr; bar.members = 0u;
    if (single) bar = xcd_barrier_post((unsigned*)(args.ws + WS_CTL) + CW_BAR, MISC + 8, F0.tid == 0);
#define CODE_() ({ int c_ = args.code; asm volatile("" : "+s"(c_)); c_; })
#define RUN(c, l) (single || (CODE_() == (c) && args.layer == (l)))
#ifndef SKIP_H
#define SKIP_H 0
#endif
#ifndef SKIP_M
#define SKIP_M 0
#endif
#ifndef PROBE_SCALE
#define PROBE_SCALE 0.05f
#endif
#ifdef PROBE_STAMPS
    LAS unsigned long long* const tsl = (LAS unsigned long long*)(F0.lds + LDSCTL_OFF + 2048); int nst = 0;
#define STAMP() do { if (blockIdx.x == 0 && F0.wave == 0 && __lane_id() == 0) tsl[nst] = __builtin_amdgcn_s_memrealtime(); ++nst; } while (0)
#else
#define STAMP() do {} while (0)
#endif
    STAMP();
#define LEADER_() (F0.wave == 0 && __lane_id() == 0)
#define GRID_BAR() do { if (single) { unsigned long long bp_ = (unsigned long long)args.ws; asm volatile("" : "+s"(bp_)); XcdBarrier b_ = bar; b_.bar = (unsigned*)(bp_ + WS_CTL) + CW_BAR;     \
        xcd_barrier(b_, LEADER_()); } STAMP(); } while (0)

#define PHASE_LOCALS const Frame F = phase_frame(F0); unsigned char* const ws = F.ws; bf16* const A1 = (bf16*)(ws + WS_A1); bf16* const Z = (bf16*)(ws + WS_Z); float* const XC = (float*)(ws + WS_XC); \
    const float* const x_in = F.in(IN_X); const float* const ctx_in = F.in(IN_CTX); float* const outp = (float*)F.in(22); (void)A1; (void)Z; (void)XC; (void)x_in; (void)ctx_in; (void)outp;

    if (EN(PH_P0) && RUN(PH_P0, 0)) { PHASE_LOCALS phase_p0(F); GRID_BAR(); }
#ifdef PROBE_EXTRA_BAR
    GRID_BAR(); GRID_BAR();
#endif
    if (EN(PH_P1) && RUN(PH_P1, 0)) { PHASE_LOCALS row_phase<false, false, false, true, 0>(F, 0, 1, x_in, ctx_in, A1, outp, XC, A1, 0, true); convert_layer0_weights(F); GRID_BAR(); }

#pragma unroll 1
    for (int l = 0; l < DEPTH; ++l) {
        const bool last = (l == DEPTH - 1);
        if (EN(PH_INPROJ) && RUN(PH_INPROJ, l)) { PHASE_LOCALS
            const int kk = IP_K(l), Mi = 8 * 2 * kk * 256 + (l ? 0 : M_CTX);
            pg8::Gemm g{A1, (const bf16*)(ws + (l ? WS_WIN1 : WS_WIN0)), Mi, ZLD, DM}; pg8::SubsetOrder S; S.init(Mi, ZLD, F.G, F.bid); S.k = kk; S.inner = 0;
            pg8::EpiZ E{Z, (const float*)(ws + WS_LBV) + l * 1024};
            pg8::gemm_phase<pg8::EpiZ, pg8::SubsetOrder, true, true>(F.lds, g, S, E, F.tid);
            if (l == 0) { if (F.bid >= 128) gates_mfma(F, l, 128, F.G - 128, 0, M_ALL / 16); }
            else gates_mfma(F, l, 0, F.G, 0, M_LAT / 16);
            GRID_BAR();
        }
        if (EN(PH_SCAN_A) && RUN(PH_SCAN_A, l)) { PHASE_LOCALS
            if (F.bid < 128) { const int b = (F.bid >> 3) & 7, h = (F.bid >> 1) & 3, dir = F.bid & 1;
                if (F.bid < 64) { if (!SKIP_H) hgrn_scan(F, l, b, h, dir, 0, !last); } else { if (!SKIP_M) mlstm_scan(F, l, b, h, dir, 0, !last); } }
            else { const int kk = IP_K(l), Mi = 8 * (16 - 2 * kk) * 256;
                pg8::Gemm g{A1, (const bf16*)(ws + (l ? WS_WIN1 : WS_WIN0)), Mi, ZLD, DM}; pg8::SubsetOrder S; S.init(Mi, ZLD, F.G - 128, F.bid - 128); S.k = kk; S.inner = 1;
                pg8::EpiZ E{Z, (const float*)(ws + WS_LBV) + l * 1024};
                pg8::gemm_phase<pg8::EpiZ, pg8::SubsetOrder, true, true>(F.lds, g, S, E, F.tid);
                signal_counter((unsigned*)(ws + WS_CTL) + CW_IP2 + 64 * l, LEADER_()); }
            if (F.bid < 128) {}
            else if (l == 0) { convert_layer1_weights(F, 128, F.G - 128, T_WIN + T_WOUT, T_L1A); ctx_pipeline<0>(F); }
            else convert_layer1_weights(F, 128, F.G - 128, T_L1A, T_L1A + (T_TOTAL - T_L1A) / 2);
            GRID_BAR();
        }
        if (EN(PH_SCAN_B) && RUN(PH_SCAN_B, l)) { PHASE_LOCALS
            if (F.bid < 128) { const int b = (F.bid >> 3) & 7, h = (F.bid >> 1) & 3, dir = F.bid & 1;
                if (F.bid < 64) { if (!SKIP_H) hgrn_scan(F, l, b, h, dir, 1, !last); } else { if (!SKIP_M) mlstm_scan(F, l, b, h, dir, 1, !last); } }
            else if (l != 0) convert_layer1_weights(F, 128, F.G - 128, T_L1A + (T_TOTAL - T_L1A) / 2, T_TOTAL);
            else ctx_pipeline<1>(F);
            GRID_BAR();
        }
        if (EN(PH_OUTPROJ) && RUN(PH_OUTPROJ, l)) { PHASE_LOCALS
            const int M = M_LAT;
            pg8::Gemm g{A1, (const bf16*)(ws + (l ? WS_WOUT1 : WS_WOUT0)), M, DM, DM}; pg8::StaticOrder S; S.init(M, DM, F.G, F.bid);
            pg8::EpiPlain E{Z, DM, 1024};
            pg8::gemm_phase<pg8::EpiPlain, pg8::StaticOrder, true, true>(F.lds, g, S, E, F.tid);
            GRID_BAR();
        }
        if (EN(PH_RESLN1) && RUN(PH_RESLN1, l)) { PHASE_LOCALS
            if (l == 0) row_phase<true, true, true, true, 0, false, true>(F, l, 0, x_in, ctx_in, Z, outp, XC, A1, l, false);
            else        row_phase<true, true, true, true, 1, true, true>(F, l, 0, outp, XC, Z, outp, XC, A1, l, false);
            GRID_BAR();
        }
        const bool moe = (l & 1) != 0;
        if (EN(PH_FFNUP) && !moe && RUN(PH_FFNUP, l)) { PHASE_LOCALS
            pg8::Gemm g{A1, (const bf16*)(ws + WS_FGU), M_LAT, 2 * DFF, DM}; pg8::StaticOrder S; S.init(M_LAT, 2 * DFF, F.G, F.bid);
            pg8::EpiSwiGLU E{Z, DFF, 1024, 1};
            pg8::gemm_phase<pg8::EpiSwiGLU, pg8::StaticOrder, true, true>(F.lds, g, S, E, F.tid);
            GRID_BAR();
        }
        if (EN(PH_FFNDN) && !moe && RUN(PH_FFNDN, l)) { PHASE_LOCALS
            pg8::Gemm g{Z, (const bf16*)(ws + WS_FDN), M_LAT, DM, DFF}; pg8::StaticOrder S; S.init(M_LAT, DM, F.G, F.bid);
            pg8::EpiPlain E{(bf16*)(ws + WS_Z + ZOFF_F2), DM, 1024};
            pg8::gemm_phase<pg8::EpiPlain, pg8::StaticOrder, true, true, false, true>(F.lds, g, S, E, F.tid);
            GRID_BAR();
        }
        if (EN(PH_RESLN2) && !moe && RUN(PH_RESLN2, l)) { PHASE_LOCALS
            row_phase<true, true, true, true, 0, true, true>(F, l, 1, outp, XC, (const bf16*)(ws + WS_Z + ZOFF_F2), outp, XC, A1, l + 1, false);
            GRID_BAR();
        }
        if (EN(PH_MOEACC) && moe && RUN(PH_MOEACC, l)) { PHASE_LOCALS
            phase_moe_dispatch(F);
            GRID_BAR();
        }
        if (EN(PH_MOEUP) && moe && RUN(PH_MOEUP, l)) { PHASE_LOCALS
            pg8::Gemm g{A1, (const bf16*)(ws + WS_MGU), 0, 2 * DEXP, DM}; pg8::MoeUpOrder S; S.init((const int*)(ws + WS_META), 11, F.G, F.bid);
            S.rfull = (unsigned*)(ws + WS_CTL) + CW_MFULL; S.rtail = (unsigned*)(ws + WS_CTL) + CW_MTAIL; S.wv = F.wave; S.nd = 0;
            pg8::EpiSwiGLU E{Z, DEXP, 11, 1};
            pg8::gemm_phase<pg8::EpiSwiGLU, pg8::MoeUpOrder, true, true, true>(F.lds, g, S, E, F.tid, (const int*)(ws + WS_SLOTTOK));
        }
        if (EN(PH_MOEDN) && moe && RUN(PH_MOEDN, l)) { PHASE_LOCALS
            wait_counter((unsigned*)(ws + WS_CTL) + CW_MFULL, (unsigned)F.G, LEADER_());
            const int nwu = __builtin_amdgcn_readfirstlane(((const int*)(ws + WS_META))[8]) * 11, ntail = nwu - (nwu / F.G) * F.G;
            pg8::Gemm g{Z, (const bf16*)(ws + WS_MDN), 0, DM, DEXP}; pg8::MoeDnOrder S; S.init((const int*)(ws + WS_META), 4, F.G, (F.bid + F.G - ntail) % F.G);
            S.rtail = (const unsigned*)(ws + WS_CTL) + CW_MTAIL; S.ntail = (unsigned)ntail; S.nwg_up = nwu; S.wv = F.wave; S.na = 0; S.got = (ntail == 0) ? 1 : 0;
            pg8::EpiPlain E{(bf16*)(ws + WS_Z + ZOFF_OPERM), DM, 4};
            pg8::gemm_phase<pg8::EpiPlain, pg8::MoeDnOrder, true, true, false, true>(F.lds, g, S, E, F.tid);
            GRID_BAR();
        }
        if (EN(PH_FINAL) && moe && RUN(PH_FINAL, l)) { PHASE_LOCALS
            row_phase<true, true, true, false, 2, true, false>(F, l, 1, outp, XC, (const bf16*)(ws + WS_Z + ZOFF_OPERM), outp, XC, A1, l, false);
        }
    }
#ifdef PROBE_STAMPS
    STAMP();
    __syncthreads();
    if (blockIdx.x == 0) { float* o = args.out;
#ifdef PROBE_SEC
        const float A = (float)tsl[40] * (1.0f / 36.0f) * 0.01f;
#else
        const float A = (float)(tsl[PROBE_A1] - tsl[PROBE_A0]) * 0.01f;
#endif
        VM_WAIT(); __syncthreads();
        if (threadIdx.x == 0) o[0] = o[0] + PROBE_SCALE * A; }
#endif
#ifdef PROBE_MSEC
    __syncthreads();
    if (blockIdx.x == 64) { float* o = args.out + (size_t)64 * 128 * DM; const float A = (float)tsl[41] * (1.0f / 36.0f) * 0.01f;
        VM_WAIT(); __syncthreads();
        if (threadIdx.x == 0) o[0] = o[0] + PROBE_SCALE * A; }
#endif
#undef RUN
#undef GRID_BAR
}

extern "C" void kernel_launch(void* const* d_in, const int* in_sizes, int n_in, void* d_out, int out_size, void* d_ws, size_t ws_size, hipStream_t stream) {
    static int grid = 0;
    if (grid == 0) {
        if (n_in != 22 || out_size != M_LAT * DM || ws_size < WS_END) { fprintf(stderr, "kernel_launch: unexpected shapes (n_in %d, out %d, ws %zu)\n", n_in, out_size, ws_size); grid = -1; return; }
        int dev = 0, cus = 0, per_cu = 0;
        if (hipGetDevice(&dev) != hipSuccess || hipDeviceGetAttribute(&cus, hipDeviceAttributeMultiprocessorCount, dev) != hipSuccess) { grid = -1; return; }
        if (hipFuncSetAttribute((const void*)hyb_fwd, hipFuncAttributeMaxDynamicSharedMemorySize, LDS_BYTES) != hipSuccess) { fprintf(stderr, "kernel_launch: hipFuncSetAttribute failed\n"); grid = -1; return; }
        if (hipOccupancyMaxActiveBlocksPerMultiprocessor(&per_cu, (const void*)hyb_fwd, NTHREADS, LDS_BYTES) != hipSuccess || per_cu < 1) fprintf(stderr, "kernel_launch: occupancy query reports %d\n", per_cu);
        (void)hipGetLastError();
        grid = cus;
        if (grid != 256) fprintf(stderr, "kernel_launch: %d CUs (built for 256)\n", grid);
    }
    if (grid < 0) return;
    (void)hipMemsetAsync((char*)d_ws + WS_CTL, 0, CTL_ZERO_BYTES, stream);
    Args a{};
    for (int i = 0; i < 22; ++i) a.in[i] = (const float*)d_in[i];
    a.out = (float*)d_out; a.ws = (unsigned char*)d_ws; a.single = 0; a.expert = 0;
#ifndef MAX_LAUNCHES
#define MAX_LAUNCHES 1000
#endif
    int nl = 0;
    auto launch = [&](int code, int layer, int expert) { if (nl++ >= MAX_LAUNCHES) return; a.code = code; a.layer = layer; a.expert = expert; hipLaunchKernelGGL(hyb_fwd, dim3(grid), dim3(NTHREADS), LDS_BYTES, stream, a); };
#ifndef MULTI_LAUNCH
    a.single = 1; a.code = 0; a.layer = 0; a.expert = 0;
    hipLaunchKernelGGL(hyb_fwd, dim3(grid), dim3(NTHREADS), LDS_BYTES, stream, a);
    return;
#endif
    launch(PH_P0, 0, 0); launch(PH_P1, 0, 0);
    launch(PH_INPROJ, 0, 0); launch(PH_SCAN_A, 0, 0); launch(PH_SCAN_B, 0, 0); launch(PH_OUTPROJ, 0, 0); launch(PH_RESLN1, 0, 0); launch(PH_FFNUP, 0, 0); launch(PH_FFNDN, 0, 0); launch(PH_RESLN2, 0, 0);
    launch(PH_INPROJ, 1, 0); launch(PH_SCAN_A, 1, 0); launch(PH_SCAN_B, 1, 0); launch(PH_OUTPROJ, 1, 0); launch(PH_RESLN1, 1, 0);
    launch(PH_MOEACC, 1, 0); launch(PH_MOEUP, 1, 0); launch(PH_MOEDN, 1, 0);
    launch(PH_FINAL, 1, 0);
}
```
